# Optimizing an MI355X kernel written in HIP

```python
import jax, jax.numpy as jnp
from jax import lax
import numpy as np

D_MODEL = 2048
BATCH = 2
SEQ = 8192
DEPTH = 1

HEAD_DIM = 128
N_HEADS_DIL = 8
N_HEADS_FOX = 8
D_DIL = N_HEADS_DIL * HEAD_DIM
D_FOX = N_HEADS_FOX * HEAD_DIM
DIL_PATTERNS = ((128, 1), (512, 4), (2048, 16))
MAX_WINDOW = 2048
Q_BLOCK = 128
ROPE_THETA = 500000.0
ROPE_DIM = HEAD_DIM // 4
D_FF = 5632
NORM_EPS = 1e-6
IN_SPLITS = (D_DIL, D_DIL, D_DIL, D_FOX, D_FOX, D_FOX, N_HEADS_FOX, D_MODEL, D_MODEL)
IN_COLS = sum(IN_SPLITS)

kernel_name = "hybrid_dilated_fox_gated_macaron"


def rmsnorm(x, g):
    xf = x.astype(jnp.float32)
    y = xf * lax.rsqrt(jnp.mean(xf * xf, axis=-1, keepdims=True) + NORM_EPS)
    return (y * g.astype(jnp.float32)).astype(x.dtype)


def swiglu(x, w_gate, w_up, w_down):
    return (jax.nn.silu(x @ w_gate) * (x @ w_up)) @ w_down


def split_heads(t, n_heads):
    b, s, _ = t.shape
    return t.reshape(b, s, n_heads, HEAD_DIM).transpose(0, 2, 1, 3)


def merge_heads(t):
    b, h, s, d = t.shape
    return t.transpose(0, 2, 1, 3).reshape(b, s, h * d)


def partial_rope(t):
    s = t.shape[2]
    half = ROPE_DIM // 2
    pos = jnp.arange(s, dtype=jnp.float32)
    inv_freq = ROPE_THETA ** (-jnp.arange(0, ROPE_DIM, 2, dtype=jnp.float32) / ROPE_DIM)
    ang = pos[:, None] * inv_freq[None, :]
    cos, sin = jnp.cos(ang), jnp.sin(ang)
    rot = t[..., :ROPE_DIM].astype(jnp.float32)
    x1, x2 = rot[..., :half], rot[..., half:]
    rotated = jnp.concatenate([x1 * cos - x2 * sin, x2 * cos + x1 * sin], axis=-1)
    return jnp.concatenate([rotated.astype(t.dtype), t[..., ROPE_DIM:]], axis=-1)


def dilated_attention(q, k, v):
    b, h, s, dh = q.shape
    n_blocks = s // Q_BLOCK
    pad = ((0, 0), (0, 0), (MAX_WINDOW, 0), (0, 0))
    kp = jnp.pad(k, pad)
    vp = jnp.pad(v, pad)
    qb = q.reshape(b, h, n_blocks, Q_BLOCK, dh).transpose(2, 0, 1, 3, 4)

    def block(args):
        qblk, blk = args
        t0 = blk * Q_BLOCK
        nums, dens, maxs = [], [], []
        for w, d in DIL_PATTERNS:
            length = w + Q_BLOCK
            rows = length // d
            nq = Q_BLOCK // d
            start = t0 + MAX_WINDOW - w
            kr = lax.dynamic_slice_in_dim(kp, start, length, axis=2).reshape(b, h, rows, d, dh)
            vr = lax.dynamic_slice_in_dim(vp, start, length, axis=2).reshape(b, h, rows, d, dh)
            qr = qblk.reshape(b, h, nq, d, dh)
            sc = jnp.einsum('bhicd,bhrcd->bhcir', qr, kr, preferred_element_type=jnp.float32)
            r = jnp.arange(rows)
            ip = jnp.arange(nq)
            cc = jnp.arange(d)
            band = (r[None, :] >= ip[:, None]) & (r[None, :] <= ip[:, None] + w // d)
            valid = (t0 - w + r[None, :] * d + cc[:, None]) >= 0
            mask = band[None, :, :] & valid[:, None, :]
            sc = jnp.where(mask, sc, -jnp.inf)
            m = jnp.max(sc, axis=-1, keepdims=True)
            p = jnp.exp(sc - m)
            den = jnp.sum(p, axis=-1)
            num = jnp.einsum('bhcir,bhrcd->bhicd', p, vr.astype(jnp.float32))
            nums.append(num.reshape(b, h, Q_BLOCK, dh))
            dens.append(den.transpose(0, 1, 3, 2).reshape(b, h, Q_BLOCK))
            maxs.append(m[..., 0].transpose(0, 1, 3, 2).reshape(b, h, Q_BLOCK))
        num = jnp.stack(nums)
        den = jnp.stack(dens)
        mx = jnp.stack(maxs)
        wgt = jnp.exp(mx - jnp.max(mx, axis=0, keepdims=True))
        out = jnp.sum(num * wgt[..., None], axis=0) / jnp.sum(den * wgt, axis=0)[..., None]
        return out.astype(q.dtype)

    out = lax.map(block, (qb, jnp.arange(n_blocks)))
    return out.transpose(1, 2, 0, 3, 4).reshape(b, h, s, dh)


def forgetting_attention(q, k, v, log_f):
    b, h, s, dh = q.shape
    n_blocks = s // Q_BLOCK
    c = jnp.cumsum(log_f, axis=-1)
    qb = q.reshape(b, h, n_blocks, Q_BLOCK, dh).transpose(2, 0, 1, 3, 4)
    cb = c.reshape(b, h, n_blocks, Q_BLOCK).transpose(2, 0, 1, 3)
    kpos = jnp.arange(s)

    def block(args):
        qblk, cq, blk = args
        sc = jnp.einsum('bhqd,bhkd->bhqk', qblk, k, preferred_element_type=jnp.float32)
        sc = sc + cq[..., :, None] - c[:, :, None, :]
        qpos = blk * Q_BLOCK + jnp.arange(Q_BLOCK)
        sc = jnp.where(kpos[None, :] <= qpos[:, None], sc, -jnp.inf)
        p = jax.nn.softmax(sc, axis=-1)
        return jnp.einsum('bhqk,bhkd->bhqd', p.astype(v.dtype), v)

    out = lax.map(block, (qb, cb, jnp.arange(n_blocks)))
    return out.transpose(1, 2, 0, 3, 4).reshape(b, h, s, dh)


def setup_inputs(seed: int = 0) -> dict:
    key = jax.random.key(seed)
    ks = jax.random.split(key, 20)
    f32 = jnp.float32

    def w(k, shape, fan_in):
        return jax.random.normal(k, shape, f32) * fan_in ** -0.5

    def gain(k):
        return 1.0 + 0.02 * jax.random.normal(k, (DEPTH, D_MODEL), f32)

    return {
        "x": jax.random.normal(ks[0], (BATCH, SEQ, D_MODEL), f32),
        "ffn1_norm": gain(ks[1]),
        "ffn1_w_gate": w(ks[2], (DEPTH, D_MODEL, D_FF), D_MODEL),
        "ffn1_w_up": w(ks[3], (DEPTH, D_MODEL, D_FF), D_MODEL),
        "ffn1_w_down": w(ks[4], (DEPTH, D_FF, D_MODEL), D_FF),
        "mix_norm": gain(ks[5]),
        "w_in": w(ks[6], (DEPTH, D_MODEL, IN_COLS), D_MODEL),
        "b_forget": 4.0 + jax.random.normal(ks[7], (DEPTH, N_HEADS_FOX), f32),
        "b_gate_dil": 0.02 * jax.random.normal(ks[8], (DEPTH, D_MODEL), f32),
        "b_gate_fox": 0.02 * jax.random.normal(ks[9], (DEPTH, D_MODEL), f32),
        "w_proj_dil": w(ks[10], (DEPTH, D_DIL, D_MODEL), D_DIL),
        "w_proj_fox": w(ks[11], (DEPTH, D_FOX, D_MODEL), D_FOX),
        "w_out": w(ks[12], (DEPTH, D_MODEL, D_MODEL), D_MODEL),
        "ffn2_norm": gain(ks[13]),
        "ffn2_w_gate": w(ks[14], (DEPTH, D_MODEL, D_FF), D_MODEL),
        "ffn2_w_up": w(ks[15], (DEPTH, D_MODEL, D_FF), D_MODEL),
        "ffn2_w_down": w(ks[16], (DEPTH, D_FF, D_MODEL), D_FF),
        "final_norm": 1.0 + 0.02 * jax.random.normal(ks[17], (D_MODEL,), f32),
    }


def reference(x, ffn1_norm, ffn1_w_gate, ffn1_w_up, ffn1_w_down, mix_norm, w_in,
              b_forget, b_gate_dil, b_gate_fox, w_proj_dil, w_proj_fox, w_out,
              ffn2_norm, ffn2_w_gate, ffn2_w_up, ffn2_w_down, final_norm):
    split_points = list(np.cumsum(IN_SPLITS)[:-1])
    scale = HEAD_DIM ** -0.5
    for l in range(DEPTH):
        x = x + 0.5 * swiglu(rmsnorm(x, ffn1_norm[l]), ffn1_w_gate[l], ffn1_w_up[l], ffn1_w_down[l])

        h = rmsnorm(x, mix_norm[l])
        proj = h @ w_in[l]
        q_d, k_d, v_d, q_f, k_f, v_f, f_logit, g_d, g_f = jnp.split(proj, split_points, axis=-1)

        qa = partial_rope(split_heads(q_d, N_HEADS_DIL)) * scale
        ka = partial_rope(split_heads(k_d, N_HEADS_DIL))
        va = split_heads(v_d, N_HEADS_DIL)
        y_dil = merge_heads(dilated_attention(qa, ka, va))

        log_f = jax.nn.log_sigmoid((f_logit + b_forget[l]).astype(jnp.float32))
        log_f = log_f.transpose(0, 2, 1)
        qb_ = split_heads(q_f, N_HEADS_FOX) * scale
        kb_ = split_heads(k_f, N_HEADS_FOX)
        vb_ = split_heads(v_f, N_HEADS_FOX)
        y_fox = merge_heads(forgetting_attention(qb_, kb_, vb_, log_f))

        merged = (jax.nn.sigmoid(g_d + b_gate_dil[l]) * (y_dil @ w_proj_dil[l])
                  + jax.nn.sigmoid(g_f + b_gate_fox[l]) * (y_fox @ w_proj_fox[l]))
        x = x + merged @ w_out[l]

        x = x + 0.5 * swiglu(rmsnorm(x, ffn2_norm[l]), ffn2_w_gate[l], ffn2_w_up[l], ffn2_w_down[l])
    return rmsnorm(x, final_norm)
```

```cpp
#include <hip/hip_runtime.h>
#include <hip/hip_bf16.h>
#include <hip/hip_cooperative_groups.h>
#include <cstdio>
#include <cstdint>
namespace cg = cooperative_groups;

#define LAS __attribute__((address_space(3)))
typedef unsigned short bf16_t;
typedef short bf16x8 __attribute__((ext_vector_type(8)));
typedef short s16x4 __attribute__((ext_vector_type(4)));
typedef float f32x4 __attribute__((ext_vector_type(4)));
typedef float f32x16 __attribute__((ext_vector_type(16)));
typedef unsigned u32x4 __attribute__((ext_vector_type(4)));
typedef unsigned u32x2 __attribute__((ext_vector_type(2)));

constexpr int T = 16384, SEQ = 8192, DM = 2048, FF = 5632, NH = 8, HD = 128;
constexpr int NGU = 2 * FF;
constexpr int NIN = 10496;
constexpr int INC = 10248;
constexpr float EPS = 1e-6f;
constexpr float LOG2E = 1.4426950408889634f;
constexpr float QSCALE = 0.08838834764831845f * LOG2E;

constexpr size_t MiB = 1u << 20;
constexpr size_t WS_SSQ = 0;
constexpr size_t WS_BAR = 512 * 1024;
constexpr size_t WS_ROPE = 1 * MiB;
constexpr size_t WS_LOGF = 2 * MiB;
constexpr size_t WS_WGU = 3 * MiB;
constexpr size_t WS_WD = 47 * MiB;
constexpr size_t WS_WIN = 69 * MiB;
constexpr size_t WS_WP = 110 * MiB;
constexpr size_t WS_WOUT = 118 * MiB;
constexpr size_t WS_XB = 126 * MiB;
constexpr size_t WS_BIG = 190 * MiB;
constexpr size_t WS_GATES = 382 * MiB;
constexpr size_t WS_END = 510 * MiB;

typedef float f32x2_t __attribute__((ext_vector_type(2))); typedef __bf16 bf16x2_t __attribute__((ext_vector_type(2)));
__device__ __forceinline__ unsigned cvt_pk_bf16(float lo, float hi) { f32x2_t v = {lo, hi}; bf16x2_t b = __builtin_convertvector(v, bf16x2_t); return __builtin_bit_cast(unsigned, b); }
__device__ __forceinline__ float bf_lo(unsigned w) { return __uint_as_float(w << 16); }
__device__ __forceinline__ float bf_hi(unsigned w) { return __uint_as_float(w & 0xffff0000u); }
__device__ __forceinline__ float wave_sum(float v) {
#pragma unroll
    for (int o = 1; o < 64; o <<= 1) v += __shfl_xor(v, o);
    return v;
}

namespace pg8 {
constexpr int BM = 256, BK = 64, HALF = 128, HTB = HALF * BK * 2, STAGE_BYTES = 8 * HTB, NXCD = 8, WGM = 8;
__host__ __device__ __forceinline__ int lds_byte(int r, int c) { const int st = (r >> 4) * 2 + (c >> 5), rr = r & 15, cc = c & 31, ob = rr * 64 + cc * 2; return st * 1024 + (ob ^ (((ob >> 9) & 1) << 5)); }
__host__ __device__ __forceinline__ void stage_rc(int b, int& R, int& C) { const int st = b / 1024, sb = b % 1024, swz = sb ^ (((sb >> 9) & 1) << 5); R = (st >> 1) * 16 + swz / 64; C = (st & 1) * 32 + (swz % 64) / 2; }
__host__ __device__ __forceinline__ int perm32(int rho) { const int n = rho >> 4, i = rho & 15; return 8 * (i >> 2) + 4 * n + (i & 3); }

struct Unit { int pm, pn, ko, half; };
struct Gemm { const bf16_t* A; const bf16_t* Bt; int K, lda, ldb; };

struct StaticOrder {
    int nM, nN, nwg, G, c, halves;
    __device__ void init(int M, int N, int G_, int c_, int halves_ = 1) { nM = M / BM; nN = N / BM; nwg = nM * nN; G = G_; c = c_; halves = halves_; }
    __device__ bool next(int i, Unit& u) const {
        const int it = i / halves, hf = i - it * halves;
        const long L = (long)it * G + c; if (L >= nwg) return false;
        int wgid = (int)L; { const int q = nwg / NXCD, r = nwg % NXCD, xcd = wgid % NXCD, off = wgid / NXCD; wgid = (xcd < r ? xcd * (q + 1) : r * (q + 1) + (xcd - r) * q) + off; }
        const int nig = WGM * nN, gid = wgid / nig, fm = gid * WGM, gsz = (nM - fm) < WGM ? (nM - fm) : WGM;
        u.pm = fm + ((wgid % nig) % gsz); u.pn = (wgid % nig) / gsz; u.half = hf; u.ko = hf * 1024; return true;
    }
};

template <class Epi, class Sched>
__device__ __forceinline__ void gemm_phase(LAS unsigned char* lds, const Gemm g, const Sched& S, const Epi& E) {
    int tid_ = threadIdx.x; asm volatile("" : "+v"(tid_));
    const int tid = tid_, wid = __builtin_amdgcn_readfirstlane(tid >> 6), lane = tid & 63, wr = wid >> 2, wc = wid & 3, fr = lane & 15, fq = lane >> 4;
    const int nt = g.K / BK;
    unsigned voffA[2], voffB[2];
#pragma unroll
    for (int i = 0; i < 2; ++i) { int R, C; stage_rc(tid * 16 + i * 8192, R, C); const int Rb = (R & ~31) + perm32(R & 31);
        voffA[i] = (unsigned)(R * g.lda + C) * 2u; voffB[i] = (unsigned)(Rb * g.ldb + C) * 2u; }
    const size_t kstep = (size_t)(BK * 2);
    const size_t hstepA = (size_t)HALF * g.lda * 2, hstepB = (size_t)HALF * g.ldb * 2;
    const size_t tstepA = 2 * hstepA, tstepB = 2 * hstepB;
    const unsigned ldsw = (unsigned)wid * 1024u;
    const int aoff = lds_byte(wr * 64 + fr, fq * 8), boff = lds_byte(wc * 32 + fr, fq * 8);
#define PG8_SA(b, h) (((b) * 2 + (h)) * HTB)
#define PG8_SB(b, h) ((4 + (b) * 2 + (h)) * HTB)
#define PG8_STAGE(bufoff, gbase, voff) do { _Pragma("unroll") for (int _i = 0; _i < 2; ++_i) \
        __builtin_amdgcn_global_load_lds((const unsigned*)((const char*)(gbase) + (voff)[_i]), (LAS unsigned*)(lds + (bufoff) + ldsw + _i * 8192), 16, 0, 0); } while (0)
#define PG8_LDA(dst, b, h) do { _Pragma("unroll") for (int m = 0; m < 4; ++m) _Pragma("unroll") for (int k = 0; k < 2; ++k) dst[m][k] = *(const LAS bf16x8*)(lds + PG8_SA(b, h) + aoff + m * 2048 + k * 1024); } while (0)
#define PG8_LDB(dst, b, h) do { _Pragma("unroll") for (int n = 0; n < 2; ++n) _Pragma("unroll") for (int k = 0; k < 2; ++k) dst[n][k] = *(const LAS bf16x8*)(lds + PG8_SB(b, h) + boff + n * 2048 + k * 1024); } while (0)
#define PG8_MMA(ai, bj, At, Bt) do { __builtin_amdgcn_s_setprio(1); _Pragma("unroll") for (int m = 0; m < 4; ++m) _Pragma("unroll") for (int n = 0; n < 2; ++n) _Pragma("unroll") for (int k = 0; k < 2; ++k) \
        acc[ai][bj][m][n] = __builtin_amdgcn_mfma_f32_16x16x32_bf16(Bt[n][k], At[m][k], acc[ai][bj][m][n], 0, 0, 0); __builtin_amdgcn_s_setprio(0); } while (0)
#define PG8_WAIT_V(n) asm volatile("s_waitcnt vmcnt(" #n ")" ::: "memory")
#define PG8_WAIT_L(n) asm volatile("s_waitcnt lgkmcnt(" #n ")" ::: "memory")
#define PG8_BAR __builtin_amdgcn_s_barrier()
#define PG8_SCHED __builtin_amdgcn_sched_barrier(0)
    Unit cur, nxt; int ui = 0;
    if (!S.next(0, cur)) return;
    constexpr int RELAX = (8 + Epi::STORES) > 63 ? 63 : (8 + Epi::STORES);
#define PG8_WAIT_V8F do { if (Epi::STORES > 0 && t == 0) asm volatile("s_waitcnt vmcnt(%0)" :: "i"(RELAX) : "memory"); else asm volatile("s_waitcnt vmcnt(8)" ::: "memory"); } while (0)
    f32x4 acc[2][2][4][2];
#pragma unroll
    for (int a = 0; a < 2; ++a)
#pragma unroll
        for (int b = 0; b < 2; ++b)
#pragma unroll
            for (int m = 0; m < 4; ++m)
#pragma unroll
                for (int n = 0; n < 2; ++n) acc[a][b][m][n] = (f32x4){0.f, 0.f, 0.f, 0.f};
    bf16x8 At[4][2], B0[2][2], B1[2][2];
    const char* cA = (const char*)g.A + (size_t)cur.pm * tstepA + (size_t)cur.ko * 2; const char* cB = (const char*)g.Bt + (size_t)cur.pn * tstepB + (size_t)cur.ko * 2;
    PG8_STAGE(PG8_SB(0, 0), cB, voffB); PG8_STAGE(PG8_SB(0, 1), cB + hstepB, voffB); PG8_STAGE(PG8_SA(0, 0), cA, voffA); PG8_STAGE(PG8_SA(0, 1), cA + hstepA, voffA);
    if (wr == 1) PG8_BAR;
    PG8_WAIT_V(2); PG8_BAR;
    PG8_STAGE(PG8_SB(1, 0), cB + kstep, voffB); PG8_STAGE(PG8_SA(1, 0), cA + kstep, voffA); PG8_STAGE(PG8_SB(1, 1), cB + hstepB + kstep, voffB);
    if (Epi::STORES > 0) { PG8_WAIT_V(0); } else { PG8_WAIT_V(6); } PG8_BAR;
    for (;;) {
        const bool has_next = S.next(ui + 1, nxt);
        const char* nA = has_next ? (const char*)g.A + (size_t)nxt.pm * tstepA + (size_t)nxt.ko * 2 : cA; const char* nB = has_next ? (const char*)g.Bt + (size_t)nxt.pn * tstepB + (size_t)nxt.ko * 2 : cB;
        for (int t = 0; t < nt; t += 2) {
            const bool last = (t == nt - 2);
            const char* a1 = cA + (size_t)(t + 1) * kstep;
            const char* a2 = last ? nA : cA + (size_t)(t + 2) * kstep; const char* b2 = last ? nB : cB + (size_t)(t + 2) * kstep;
            const char* a3 = a2 + kstep; const char* b3 = b2 + kstep;
            PG8_LDB(B0, 0, 0); PG8_LDB(B1, 0, 1); PG8_SCHED; PG8_LDA(At, 0, 0); PG8_STAGE(PG8_SA(1, 1), a1 + hstepA, voffA);
            PG8_WAIT_V8F; PG8_WAIT_L(0); PG8_BAR; PG8_MMA(0, 0, At, B0); PG8_MMA(0, 1, At, B1); PG8_BAR; PG8_SCHED;
            PG8_LDA(At, 0, 1); PG8_STAGE(PG8_SB(0, 0), b2, voffB); PG8_STAGE(PG8_SB(0, 1), b2 + hstepB, voffB); PG8_STAGE(PG8_SA(0, 0), a2, voffA);
            PG8_WAIT_V8F; PG8_WAIT_L(0); PG8_BAR; PG8_MMA(1, 0, At, B0); PG8_MMA(1, 1, At, B1); PG8_BAR; PG8_SCHED;
            PG8_LDB(B0, 1, 0); PG8_LDB(B1, 1, 1); PG8_SCHED; PG8_LDA(At, 1, 0); PG8_STAGE(PG8_SA(0, 1), a2 + hstepA, voffA);
            PG8_WAIT_V(8); PG8_WAIT_L(0); PG8_BAR; PG8_MMA(0, 0, At, B0); PG8_MMA(0, 1, At, B1); PG8_BAR; PG8_SCHED;
            PG8_LDA(At, 1, 1); PG8_STAGE(PG8_SB(1, 0), b3, voffB); PG8_STAGE(PG8_SB(1, 1), b3 + hstepB, voffB); PG8_STAGE(PG8_SA(1, 0), a3, voffA);
            PG8_WAIT_V(8); PG8_WAIT_L(0); PG8_BAR; PG8_MMA(1, 0, At, B0); PG8_MMA(1, 1, At, B1); PG8_BAR; PG8_SCHED;
        }
        if (wr == 0) PG8_BAR;
        E(acc, cur, wr, wc, fr, fq);
        if (!has_next) break;
#pragma unroll
        for (int a = 0; a < 2; ++a)
#pragma unroll
            for (int b = 0; b < 2; ++b)
#pragma unroll
                for (int m = 0; m < 4; ++m)
#pragma unroll
                    for (int n = 0; n < 2; ++n) acc[a][b][m][n] = (f32x4){0.f, 0.f, 0.f, 0.f};
        cur = nxt; cA = nA; cB = nB; ++ui;
        if (wr == 1) PG8_BAR;
    }
    PG8_WAIT_V(0);
    PG8_BAR;
#undef PG8_SA
#undef PG8_SB
#undef PG8_STAGE
#undef PG8_LDA
#undef PG8_LDB
#undef PG8_MMA
#undef PG8_WAIT_V
#undef PG8_WAIT_L
#undef PG8_BAR
#undef PG8_SCHED
}

typedef const f32x4 (&AccRef)[2][2][4][2];

__device__ __forceinline__ float rstd_of(const float* ssq, int r) { return rsqrtf(ssq[r] * (1.f / (float)DM) + EPS); }
__device__ __forceinline__ float silu_mul(float g, float u) { return g * __builtin_amdgcn_rcpf(1.f + __builtin_amdgcn_exp2f(-g * LOG2E)) * u; }
__device__ __forceinline__ float sigmoidf_(float z) { return __builtin_amdgcn_rcpf(1.f + __builtin_amdgcn_exp2f(-z * LOG2E)); }

struct EpiSwiGLU {
    static constexpr int STORES = 8;
    bf16_t* O; const float* ssq;
    __device__ __forceinline__ void operator()(AccRef acc, const Unit& u, int wr, int wc, int fr, int fq) const {
        const int row0 = u.pm * BM + wr * 64 + fr, col = u.pn * HALF + wc * 32 + 8 * fq;
        float rsv[8];
#pragma unroll
        for (int i = 0; i < 8; ++i) rsv[i] = ssq[row0 + (i >> 2) * HALF + (i & 3) * 16];
#pragma unroll
        for (int i = 0; i < 8; ++i) rsv[i] = rsqrtf(rsv[i] * (1.f / (float)DM) + EPS);
#pragma unroll
        for (int ai = 0; ai < 2; ++ai)
#pragma unroll
            for (int m = 0; m < 4; ++m) { const int r = row0 + ai * HALF + m * 16; const float rs = rsv[ai * 4 + m];
                const f32x4 g0 = acc[ai][0][m][0] * rs, g1 = acc[ai][0][m][1] * rs, u0 = acc[ai][1][m][0] * rs, u1 = acc[ai][1][m][1] * rs;
                u32x4 w; w.x = cvt_pk_bf16(silu_mul(g0[0], u0[0]), silu_mul(g0[1], u0[1])); w.y = cvt_pk_bf16(silu_mul(g0[2], u0[2]), silu_mul(g0[3], u0[3]));
                w.z = cvt_pk_bf16(silu_mul(g1[0], u1[0]), silu_mul(g1[1], u1[1])); w.w = cvt_pk_bf16(silu_mul(g1[2], u1[2]), silu_mul(g1[3], u1[3]));
                __builtin_nontemporal_store(w, (u32x4*)(O + (size_t)r * FF + col)); }
    }
};
struct EpiResid {
    static constexpr int STORES = 40;
    const float* resid; float* out; bf16_t* xb; float* ssq; float alpha;
    __device__ __forceinline__ void operator()(AccRef acc, const Unit& u, int wr, int wc, int fr, int fq) const {
        const int row0 = u.pm * BM + wr * 64 + fr, col0 = u.pn * BM + wc * 32 + 8 * fq;
        f32x4 cur[4], nxt[4];
        { const size_t off = (size_t)row0 * DM + col0; cur[0] = *(const f32x4*)(resid + off); cur[1] = *(const f32x4*)(resid + off + 4); cur[2] = *(const f32x4*)(resid + off + HALF); cur[3] = *(const f32x4*)(resid + off + HALF + 4); }
#pragma unroll
        for (int i = 0; i < 8; ++i) { const int ai = i >> 2, m = i & 3; const int r = row0 + ai * HALF + m * 16; float sq = 0.f;
            if (i < 7) { const int rn = row0 + ((i + 1) >> 2) * HALF + ((i + 1) & 3) * 16; const size_t off = (size_t)rn * DM + col0;
                nxt[0] = *(const f32x4*)(resid + off); nxt[1] = *(const f32x4*)(resid + off + 4); nxt[2] = *(const f32x4*)(resid + off + HALF); nxt[3] = *(const f32x4*)(resid + off + HALF + 4); }
            asm volatile("" ::: "memory");
#pragma unroll
            for (int bj = 0; bj < 2; ++bj) { const size_t off = (size_t)r * DM + col0 + bj * HALF;
                const f32x4 o0 = cur[2 * bj] + acc[ai][bj][m][0] * alpha, o1 = cur[2 * bj + 1] + acc[ai][bj][m][1] * alpha;
                *(f32x4*)(out + off) = o0; *(f32x4*)(out + off + 4) = o1;
                sq += (o0[0] * o0[0] + o0[1] * o0[1]) + (o0[2] * o0[2] + o0[3] * o0[3]) + (o1[0] * o1[0] + o1[1] * o1[1]) + (o1[2] * o1[2] + o1[3] * o1[3]);
                if (xb) { u32x4 w; w.x = cvt_pk_bf16(o0[0], o0[1]); w.y = cvt_pk_bf16(o0[2], o0[3]); w.z = cvt_pk_bf16(o1[0], o1[1]); w.w = cvt_pk_bf16(o1[2], o1[3]); *(u32x4*)(xb + off) = w; } }
            sq += __shfl_xor(sq, 16); sq += __shfl_xor(sq, 32);
            if (fq == 0) atomicAdd(ssq + r, sq);
#pragma unroll
            for (int k = 0; k < 4; ++k) cur[k] = nxt[k]; }
    }
};
struct EpiWin {
    static constexpr int STORES = 0;
    bf16_t* qkv; bf16_t* gates; float* logf; const float* ssq; const float* rope; const float* b_forget; const float* b_gd; const float* b_gf;
    __device__ __forceinline__ void operator()(AccRef acc, const Unit& u, int wr, int wc, int fr, int fq) const {
        const int row0 = u.pm * BM + wr * 64 + fr, pn = u.pn;
        float rsv[8];
#pragma unroll
        for (int i = 0; i < 8; ++i) rsv[i] = ssq[row0 + (i >> 2) * HALF + (i & 3) * 16];
#pragma unroll
        for (int i = 0; i < 8; ++i) rsv[i] = rsqrtf(rsv[i] * (1.f / (float)DM) + EPS);
        if (pn < 24) {
            const int which = pn >> 2; const bool rot = (which < 2) && (wc == 0); const float qs = (which == 0 || which == 3) ? QSCALE : 1.f;
            bf16_t* base = qkv + (size_t)which * ((size_t)T * 1024);
            f32x4 cs0 = {1.f, 0.f, 1.f, 0.f}, cs1 = {1.f, 0.f, 1.f, 0.f}, ns0 = cs0, ns1 = cs1;
            if (rot) { const int s0 = row0 & (SEQ - 1); cs0 = *(const f32x4*)(rope + ((size_t)s0 * 16 + 4 * fq) * 2); cs1 = *(const f32x4*)(rope + ((size_t)s0 * 16 + 4 * fq) * 2 + 4); }
#pragma unroll
            for (int i = 0; i < 8; ++i) { const int ai = i >> 2, m = i & 3; const int r = row0 + ai * HALF + m * 16; const float rs = rsv[i] * qs; const int b = r >> 13, sp = r & (SEQ - 1);
                if (rot && i < 7) { const int sn = (row0 + ((i + 1) >> 2) * HALF + ((i + 1) & 3) * 16) & (SEQ - 1);
                    ns0 = *(const f32x4*)(rope + ((size_t)sn * 16 + 4 * fq) * 2); ns1 = *(const f32x4*)(rope + ((size_t)sn * 16 + 4 * fq) * 2 + 4); }
                asm volatile("" ::: "memory");
#pragma unroll
                for (int bj = 0; bj < 2; ++bj) { const int head = 2 * (pn & 3) + bj;
                    f32x4 v0 = acc[ai][bj][m][0] * rs, v1 = acc[ai][bj][m][1] * rs;
                    if (rot) { f32x4 t0, t1;
                        t0[0] = v0[0] * cs0[0] - v0[1] * cs0[1]; t0[1] = v0[1] * cs0[0] + v0[0] * cs0[1]; t0[2] = v0[2] * cs0[2] - v0[3] * cs0[3]; t0[3] = v0[3] * cs0[2] + v0[2] * cs0[3];
                        t1[0] = v1[0] * cs1[0] - v1[1] * cs1[1]; t1[1] = v1[1] * cs1[0] + v1[0] * cs1[1]; t1[2] = v1[2] * cs1[2] - v1[3] * cs1[3]; t1[3] = v1[3] * cs1[2] + v1[2] * cs1[3];
                        v0 = t0; v1 = t1; }
                    u32x4 w; w.x = cvt_pk_bf16(v0[0], v0[1]); w.y = cvt_pk_bf16(v0[2], v0[3]); w.z = cvt_pk_bf16(v1[0], v1[1]); w.w = cvt_pk_bf16(v1[2], v1[3]);
                    *(u32x4*)(base + ((size_t)(b * NH + head) * SEQ + sp) * HD + wc * 32 + 8 * fq) = w; }
                cs0 = ns0; cs1 = ns1; }
        } else {
            const int gi = (pn - 24) >> 3, ct = (pn - 24) & 7; const float* bias = gi ? b_gf : b_gd; bf16_t* gb = gates + (size_t)gi * ((size_t)T * DM);
            const int col0 = ct * BM + wc * 32 + 8 * fq;
            f32x4 bv[2][2];
#pragma unroll
            for (int bj = 0; bj < 2; ++bj) { bv[bj][0] = *(const f32x4*)(bias + col0 + bj * HALF); bv[bj][1] = *(const f32x4*)(bias + col0 + bj * HALF + 4); }
#pragma unroll
            for (int ai = 0; ai < 2; ++ai)
#pragma unroll
                for (int m = 0; m < 4; ++m) { const int r = row0 + ai * HALF + m * 16; const float rs = rsv[ai * 4 + m];
#pragma unroll
                    for (int bj = 0; bj < 2; ++bj) { const f32x4 v0 = acc[ai][bj][m][0] * rs + bv[bj][0], v1 = acc[ai][bj][m][1] * rs + bv[bj][1];
                        u32x4 w; w.x = cvt_pk_bf16(sigmoidf_(v0[0]), sigmoidf_(v0[1])); w.y = cvt_pk_bf16(sigmoidf_(v0[2]), sigmoidf_(v0[3]));
                        w.z = cvt_pk_bf16(sigmoidf_(v1[0]), sigmoidf_(v1[1])); w.w = cvt_pk_bf16(sigmoidf_(v1[2]), sigmoidf_(v1[3]));
                        *(u32x4*)(gb + (size_t)r * DM + col0 + bj * HALF) = w; } }
        }
    }
};
struct EpiProj {
    static constexpr int STORES = 16;
    const bf16_t* gates; bf16_t* merged;
    __device__ __forceinline__ void operator()(AccRef acc, const Unit& u, int wr, int wc, int fr, int fq) const {
        const int row0 = u.pm * BM + wr * 64 + fr, col0 = u.pn * BM + wc * 32 + 8 * fq;
        const bf16_t* gb = gates + (size_t)u.half * ((size_t)T * DM);
        const u32x4 zz = {0u, 0u, 0u, 0u};
        u32x4 cg[2], cp[2] = {zz, zz}, ng[2], np[2] = {zz, zz};
        { const size_t off = (size_t)row0 * DM + col0; cg[0] = *(const u32x4*)(gb + off); cg[1] = *(const u32x4*)(gb + off + HALF);
          if (u.half) { cp[0] = *(const u32x4*)(merged + off); cp[1] = *(const u32x4*)(merged + off + HALF); } }
#pragma unroll
        for (int i = 0; i < 8; ++i) { const int ai = i >> 2, m = i & 3; const int r = row0 + ai * HALF + m * 16;
            if (i < 7) { const int rn = row0 + ((i + 1) >> 2) * HALF + ((i + 1) & 3) * 16; const size_t off = (size_t)rn * DM + col0;
                ng[0] = *(const u32x4*)(gb + off); ng[1] = *(const u32x4*)(gb + off + HALF);
                if (u.half) { np[0] = *(const u32x4*)(merged + off); np[1] = *(const u32x4*)(merged + off + HALF); } }
            asm volatile("" ::: "memory");
#pragma unroll
            for (int bj = 0; bj < 2; ++bj) { const size_t off = (size_t)r * DM + col0 + bj * HALF;
                const u32x4 gv = cg[bj], pv = cp[bj];
                f32x4 v0 = acc[ai][bj][m][0], v1 = acc[ai][bj][m][1];
                v0[0] *= bf_lo(gv.x); v0[1] *= bf_hi(gv.x); v0[2] *= bf_lo(gv.y); v0[3] *= bf_hi(gv.y);
                v1[0] *= bf_lo(gv.z); v1[1] *= bf_hi(gv.z); v1[2] *= bf_lo(gv.w); v1[3] *= bf_hi(gv.w);
                if (u.half) {
                    v0[0] += bf_lo(pv.x); v0[1] += bf_hi(pv.x); v0[2] += bf_lo(pv.y); v0[3] += bf_hi(pv.y);
                    v1[0] += bf_lo(pv.z); v1[1] += bf_hi(pv.z); v1[2] += bf_lo(pv.w); v1[3] += bf_hi(pv.w); }
                u32x4 w; w.x = cvt_pk_bf16(v0[0], v0[1]); w.y = cvt_pk_bf16(v0[2], v0[3]); w.z = cvt_pk_bf16(v1[0], v1[1]); w.w = cvt_pk_bf16(v1[2], v1[3]);
                *(u32x4*)(merged + off) = w; }
            cg[0] = ng[0]; cg[1] = ng[1]; cp[0] = np[0]; cp[1] = np[1]; }
    }
};
}

namespace att {
using bf16 = __hip_bfloat16;
constexpr int D = 128, NW = 8, QBLK = 32, KVBLK = 64, QB = NW * QBLK, LDO = 2048;
constexpr int SHM_V = KVBLK * D * 2, SHM_K = KVBLK * D * 2;
constexpr int LDS_WSF = 2 * SHM_V + 2 * SHM_K;
constexpr int LDS_CB = LDS_WSF + 2048;
constexpr int LDS_DT = LDS_CB + 32768;
constexpr int DT_N = 2624, DT_OFF = 320;
constexpr int LDS_SCAN = LDS_DT + DT_N * 4;
constexpr int LDS_END = LDS_SCAN + 64;
constexpr float THR2 = 11.5f;

#define KSWZ(row, colB) ((row) * 256 + ((colB) ^ (((row) & 7) << 4)))
#define SBAR() __builtin_amdgcn_sched_barrier(0)
__device__ __forceinline__ int v_st(int k, int c) { const int kk = (k & ~0xC) | ((k & 4) << 1) | ((k & 8) >> 1); return ((kk >> 3) * 4 + (c >> 5)) * 512 + ((kk & 7) * 32 + (c & 31)) * 2; }
__device__ __forceinline__ int v_rd_base(int lane) { return ((lane & 3) << 3) | (((lane >> 2) & 3) << 6) | (((lane >> 4) & 1) << 5) | (((lane >> 5) & 1) << 8); }
constexpr int v_rd_off(int d0, int ks, int half) { return d0 * 512 + ks * 4096 + half * 2048; }
__device__ __forceinline__ int crow(int r, int hi) { return (r & 3) + 8 * (r >> 2) + 4 * hi; }
__device__ __forceinline__ unsigned cvtpk(float lo, float hi) { unsigned r; asm volatile("v_cvt_pk_bf16_f32 %0, %1, %2" : "=v"(r) : "v"(lo), "v"(hi)); return r; }
__device__ __forceinline__ bf16x8 load8(const bf16* p) { return *reinterpret_cast<const bf16x8*>(p); }
__device__ __forceinline__ void mask_tile(f32x16& p0, f32x16& p1, int dq, unsigned W) {
    const float NEG = -__builtin_inff();
#pragma unroll
    for (int r = 0; r < 16; ++r) { const int c = (r & 3) + 8 * (r >> 2);
        if ((unsigned)(dq - c) >= W) p0[r] = NEG;
        if ((unsigned)(dq - c - 32) >= W) p1[r] = NEG; }
}
__device__ __forceinline__ void partialSM(f32x16& p0, f32x16& p1, float& m_reg, float& mn, float& alpha) {
    float pmax = p0[0];
#pragma unroll
    for (int r = 1; r < 16; ++r) pmax = fmaxf(pmax, p0[r]);
#pragma unroll
    for (int r = 0; r < 16; ++r) pmax = fmaxf(pmax, p1[r]);
    { auto rr = __builtin_amdgcn_permlane32_swap(__float_as_uint(pmax), __float_as_uint(pmax), false, false);
      pmax = fmaxf(__uint_as_float(rr[0]), __uint_as_float(rr[1])); }
    if (__builtin_expect(__all((pmax - m_reg) <= THR2), 1)) { mn = m_reg; alpha = 1.f; }
    else { mn = fmaxf(m_reg, pmax); alpha = __builtin_amdgcn_exp2f(m_reg - mn); m_reg = mn; }
#pragma unroll
    for (int r = 0; r < 16; ++r) p0[r] = p0[r] - mn;
#pragma unroll
    for (int r = 0; r < 16; ++r) p1[r] = p1[r] - mn;
#pragma unroll
    for (int r = 0; r < 16; ++r) p0[r] = __builtin_amdgcn_exp2f(p0[r]);
}
__device__ __forceinline__ void finishSM(f32x16& p0, f32x16& p1, float alpha, float& l_reg, bf16x8& pa0, bf16x8& pa1, bf16x8& pa2, bf16x8& pa3) {
#pragma unroll
    for (int r = 0; r < 16; ++r) p1[r] = __builtin_amdgcn_exp2f(p1[r]);
    float ps = 0;
#pragma unroll
    for (int r = 0; r < 16; ++r) ps += p0[r];
#pragma unroll
    for (int r = 0; r < 16; ++r) ps += p1[r];
    { auto rr = __builtin_amdgcn_permlane32_swap(__float_as_uint(ps), __float_as_uint(ps), false, false);
      ps = __uint_as_float(rr[0]) + __uint_as_float(rr[1]); }
    l_reg = l_reg * alpha + ps;
#define PK4(P, B_, OUT) do { unsigned a0 = cvtpk(P[B_+0], P[B_+1]), a1 = cvtpk(P[B_+2], P[B_+3]);                          \
        unsigned b0 = cvtpk(P[B_+4], P[B_+5]), b1 = cvtpk(P[B_+6], P[B_+7]);                                             \
        auto r0 = __builtin_amdgcn_permlane32_swap(a0, b0, false, false); auto r1 = __builtin_amdgcn_permlane32_swap(a1, b1, false, false); \
        u32x4 w = {r0[0], r1[0], r0[1], r1[1]}; OUT = *reinterpret_cast<bf16x8*>(&w); } while (0)
    PK4(p0, 0, pa0); PK4(p0, 8, pa1); PK4(p1, 0, pa2); PK4(p1, 8, pa3);
#undef PK4
}
template <int KB, int MODE>
__device__ __forceinline__ void qkt(f32x16& p0, f32x16& p1, const char* K_lds, int r32, int hi, const bf16x8* qr, const LAS float* cbt, const LAS float* dtab, int kb_, int qm) {
    if (MODE == 0) { const LAS float* cb_ = cbt + (kb_ + 4 * hi);
#pragma unroll
        for (int j_ = 0; j_ < 4; ++j_) { const f32x4 a_ = *(const LAS f32x4*)(cb_ + 8 * j_), b_ = *(const LAS f32x4*)(cb_ + 32 + 8 * j_);
            p0[4 * j_ + 0] = a_[0]; p0[4 * j_ + 1] = a_[1]; p0[4 * j_ + 2] = a_[2]; p0[4 * j_ + 3] = a_[3]; p1[4 * j_ + 0] = b_[0]; p1[4 * j_ + 1] = b_[1]; p1[4 * j_ + 2] = b_[2]; p1[4 * j_ + 3] = b_[3]; } }
    else { const LAS float* tb_ = dtab + (qm - kb_ + (DT_OFF - 59));
#pragma unroll
        for (int r_ = 0; r_ < 16; ++r_) { const int c_ = (r_ & 3) + 8 * (r_ >> 2); p0[r_] = tb_[59 - c_]; p1[r_] = tb_[27 - c_]; } }
    const char* kb[4];
#pragma unroll
    for (int dd = 0; dd < 4; ++dd) kb[dd] = K_lds + KB * SHM_K + KSWZ(r32, (dd * 16 + hi * 8) * 2);
#pragma unroll
    for (int d0 = 0; d0 < 8; ++d0) { const char* a = kb[d0 & 3] + (d0 >> 2) * 128;
        bf16x8 b0 = *reinterpret_cast<const bf16x8*>(a);
        bf16x8 b1 = *reinterpret_cast<const bf16x8*>(a + 32 * 256);
        p0 = __builtin_amdgcn_mfma_f32_32x32x16_bf16(b0, qr[d0], p0, 0, 0, 0);
        p1 = __builtin_amdgcn_mfma_f32_32x32x16_bf16(b1, qr[d0], p1, 0, 0, 0); }
}
template <int VB>
__device__ __forceinline__ void pv_tile(f32x16* o, int vb0, bf16x8 pa0, bf16x8 pa1, bf16x8 pa2, bf16x8 pa3) {
#define TRRD(dst, off) asm volatile("ds_read_b64_tr_b16 %0, %1 offset:%2" : "=&v"(dst) : "v"(vb0), "i"(off) : "memory")
#define PV_D0(d0) do { s16x4 l0, l1, l2, l3, h0, h1, h2, h3; constexpr int b_ = VB * SHM_V + v_rd_off(d0, 0, 0); \
        TRRD(l0, b_); TRRD(h0, b_ + 2048); TRRD(l1, b_ + 4096); TRRD(h1, b_ + 6144); TRRD(l2, b_ + 8192); TRRD(h2, b_ + 10240); TRRD(l3, b_ + 12288); TRRD(h3, b_ + 14336); \
        asm volatile("s_waitcnt lgkmcnt(0)" ::: "memory"); SBAR();   \
        o[d0] = __builtin_amdgcn_mfma_f32_32x32x16_bf16(pa0, (bf16x8){l0[0], l0[1], l0[2], l0[3], h0[0], h0[1], h0[2], h0[3]}, o[d0], 0, 0, 0);   \
        o[d0] = __builtin_amdgcn_mfma_f32_32x32x16_bf16(pa1, (bf16x8){l1[0], l1[1], l1[2], l1[3], h1[0], h1[1], h1[2], h1[3]}, o[d0], 0, 0, 0);   \
        o[d0] = __builtin_amdgcn_mfma_f32_32x32x16_bf16(pa2, (bf16x8){l2[0], l2[1], l2[2], l2[3], h2[0], h2[1], h2[2], h2[3]}, o[d0], 0, 0, 0);   \
        o[d0] = __builtin_amdgcn_mfma_f32_32x32x16_bf16(pa3, (bf16x8){l3[0], l3[1], l3[2], l3[3], h3[0], h3[1], h3[2], h3[3]}, o[d0], 0, 0, 0); } while (0)
    PV_D0(0); PV_D0(1); PV_D0(2); PV_D0(3);
#undef PV_D0
#undef TRRD
}

struct BlockRef { const bf16* Q; const bf16* K; const bf16* V; bf16* O; int P0; int W; };
struct Seam { bf16x8 qr[8]; bf16x8 st_v0, st_v1, st_k0, st_k1; };
__device__ __forceinline__ int swa_jlo(int P0, int W) { const int lowk = P0 - W + 1; return lowk > 0 ? lowk / KVBLK : 0; }
#define ROW(p, k0, rr) ((p) + (size_t)((k0) + (rr)) * D + sc)
#define VMW() asm volatile("s_waitcnt vmcnt(0)" ::: "memory")
#define VMWN(n) asm volatile("s_waitcnt vmcnt(%0)" :: "i"(n) : "memory")
#define SLOAD_H(Kp, Vp, k0) do { S.st_v0 = load8(ROW(Vp, k0, sr)); S.st_v1 = load8(ROW(Vp, k0, 32 + sr));              \
                         S.st_k0 = load8(ROW(Kp, k0, sr)); S.st_k1 = load8(ROW(Kp, k0, 32 + sr)); } while (0)
#define SWRITE_HK(bf) do { *(bf16x8*)(K_lds + (bf) * SHM_K + kws) = S.st_k0; *(bf16x8*)(K_lds + (bf) * SHM_K + kws + 32 * 256) = S.st_k1; } while (0)
#define SWRITE_HV(bf) do { *(bf16x8*)(V_lds + (bf) * SHM_V + vst0) = S.st_v0; *(bf16x8*)(V_lds + (bf) * SHM_V + vst1) = S.st_v1; } while (0)
#define SWRITE_H(bf) do { SWRITE_HV(bf); SWRITE_HK(bf); } while (0)
template <int MODE>
__device__ __forceinline__ void attn_prime(const BlockRef& cur, char* lds, Seam& S) {
    int tid_ = threadIdx.x; asm volatile("" : "+v"(tid_));
    const int tid = tid_, wid = __builtin_amdgcn_readfirstlane(tid >> 6), lane = tid & 63, r32 = lane & 31, hi = lane >> 5;
    const int sr = tid >> 4, sc = (tid & 15) * 8, kws = KSWZ(sr, sc * 2); char* K_lds = lds + 2 * SHM_V;
    const int kb0 = MODE == 0 ? cur.P0 + QB - KVBLK : swa_jlo(cur.P0, cur.W) * KVBLK;
#pragma unroll
    for (int d0 = 0; d0 < 8; ++d0) S.qr[d0] = load8(cur.Q + (size_t)(wid * QBLK + r32) * D + d0 * 16 + hi * 8);
    SLOAD_H(cur.K, cur.V, kb0); VMW(); SWRITE_HK(0);
    __syncthreads();
}
template <int MODE>
__device__ __forceinline__ void attn_block(const BlockRef& cur, const BlockRef& nxt, char* lds, const LAS float* cbt, const LAS float* dtab, Seam& S) {
    int tid_ = threadIdx.x; asm volatile("" : "+v"(tid_));
    const int tid = tid_, wid = __builtin_amdgcn_readfirstlane(tid >> 6), lane = tid & 63, r32 = lane & 31, hi = lane >> 5;
    const int W = cur.W;
    const int j_lo = swa_jlo(cur.P0, W);
    const int j_hi = (cur.P0 + QB - 1) / KVBLK + 1;
    const int NT = j_hi - j_lo;
    const int kbn = MODE == 0 ? nxt.P0 + QB - KVBLK : swa_jlo(nxt.P0, nxt.W) * KVBLK;
    const int qlo = cur.P0 + wid * QBLK, qm = qlo + r32 - 4 * hi;
    char* V_lds = lds; char* K_lds = lds + 2 * SHM_V;
    float* ws = (float*)(lds + LDS_WSF) + wid * 64; float* li_l = ws, * al_l = ws + 32;
    float m_reg = -1e30f, l_reg = 0; f32x16 o[4] = {};
    const int sr = tid >> 4, sc = (tid & 15) * 8, vst0 = v_st(sr, sc), vst1 = v_st(32 + sr, sc), kws = KSWZ(sr, sc * 2);
    const int vb0 = (int)(uintptr_t)V_lds + v_rd_base(lane);
    const bf16* Kh = cur.K; const bf16* Vh = cur.V;
#define RESC(a) do { if (__any((a) < 1.f)) { if (hi == 0) al_l[r32] = (a); asm volatile("s_waitcnt lgkmcnt(0)" ::: "memory");              \
                     for (int d_ = 0; d_ < 4; ++d_) for (int r = 0; r < 16; ++r) o[d_][r] *= al_l[crow(r, hi)]; } } while (0)
#define KBASE(t) ((MODE == 0 ? (j_hi - 1 - (t)) : (j_lo + (t))) * KVBLK)
#define MASKT(P0_, P1_, t) do { if (MODE == 0) { const int kb_ = KBASE(t); if (kb_ + KVBLK - 1 > qlo) mask_tile(P0_, P1_, qm - kb_, (unsigned)W); } } while (0)
    constexpr int NQL = 8;
#define SEAM_K0() do { VMWN(NQL); SWRITE_HK(0); SBAR(); } while (0)
    f32x16 pA0, pA1, pB0, pB1; float mnA, mnB, alA, alB; bf16x8 pa0, pa1, pa2, pa3;
    SWRITE_HV(0); SBAR();
    if (NT > 1) { SLOAD_H(Kh, Vh, KBASE(1)); }
    SBAR(); qkt<0, MODE>(pA0, pA1, K_lds, r32, hi, S.qr, cbt, dtab, KBASE(0), qm);
    MASKT(pA0, pA1, 0); partialSM(pA0, pA1, m_reg, mnA, alA);
    if (NT > 1) { VMW(); SWRITE_H(1); }
    __syncthreads();
#define HALF_STEP(PX0, PX1, mnX, alX, PY0, PY1, alY, t, KB, VB, SB) do {                                                      \
        SBAR(); qkt<KB, MODE>(PX0, PX1, K_lds, r32, hi, S.qr, cbt, dtab, KBASE(t), qm);                                             \
        finishSM(PY0, PY1, alY, l_reg, pa0, pa1, pa2, pa3); SBAR();                                                           \
        if ((t) + 1 < NT) { SLOAD_H(Kh, Vh, KBASE((t) + 1)); SBAR(); }                                               \
        pv_tile<VB>(o, vb0, pa0, pa1, pa2, pa3); MASKT(PX0, PX1, (t)); partialSM(PX0, PX1, m_reg, mnX, alX);                                        \
        __syncthreads();                                                                                                      \
        if ((t) + 1 < NT) { VMW(); SWRITE_H(SB); }                                                                          \
        RESC(alX); __syncthreads(); } while (0)
    for (int t = 1; t + 1 < NT; t += 2) {
        HALF_STEP(pB0, pB1, mnB, alB, pA0, pA1, alA, t, 1, 0, 0);
        HALF_STEP(pA0, pA1, mnA, alA, pB0, pB1, alB, t + 1, 0, 1, 1);
    }
    const bool even = (NT & 1) == 0;
    if (even) { SBAR(); qkt<1, MODE>(pB0, pB1, K_lds, r32, hi, S.qr, cbt, dtab, KBASE(NT - 1), qm); SBAR(); }
    SLOAD_H(nxt.K, nxt.V, kbn); SBAR();
#pragma unroll
    for (int d0 = 0; d0 < 8; ++d0) S.qr[d0] = load8(nxt.Q + (size_t)(wid * QBLK + r32) * D + d0 * 16 + hi * 8);
    SBAR();
    finishSM(pA0, pA1, alA, l_reg, pa0, pa1, pa2, pa3); SBAR();
    pv_tile<0>(o, vb0, pa0, pa1, pa2, pa3);
    if (even) { MASKT(pB0, pB1, NT - 1); partialSM(pB0, pB1, m_reg, mnB, alB); __syncthreads(); RESC(alB);
        finishSM(pB0, pB1, alB, l_reg, pa0, pa1, pa2, pa3); SBAR(); pv_tile<1>(o, vb0, pa0, pa1, pa2, pa3); }
    SBAR(); SEAM_K0();
    if (hi == 0) li_l[r32] = l_reg; asm volatile("s_waitcnt lgkmcnt(0)" ::: "memory");
    float rli[16];
#pragma unroll
    for (int r = 0; r < 16; ++r) rli[r] = __builtin_amdgcn_rcpf(li_l[crow(r, hi)]);
    int lo_ = 4 * hi * LDO + r32; asm volatile("" : "+v"(lo_));
#pragma unroll
    for (int r = 0; r < 16; ++r) { bf16* rowp = cur.O + (size_t)(wid * QBLK + (r & 3) + 8 * (r >> 2)) * LDO;
#pragma unroll
        for (int d0 = 0; d0 < 4; ++d0) { const float v = o[d0][r] * rli[r];
            const float vn = __shfl_xor(v, 1);
            if ((r32 & 1) == 0) *(unsigned*)(rowp + lo_ + d0 * 32) = cvtpk(v, vn); } }
    __syncthreads();
#undef RESC
#undef KBASE
#undef MASKT
#undef SEAM_K0
#undef HALF_STEP
}
#undef ROW
#undef VMW
#undef VMWN
#undef SLOAD_H
#undef SWRITE_HK
#undef SWRITE_HV
#undef SWRITE_H

__device__ __forceinline__ void build_cb(const float* lf, int n, LAS float* cbt, LAS float* scan, int tid_in) {
    int tid = tid_in; asm volatile("" : "+v"(tid));
    const int lane = tid & 63, wid = tid >> 6, i0 = tid * 16;
    f32x4 v[4]; float tot = 0.f;
    if (i0 < n) {
#pragma unroll
        for (int j = 0; j < 4; ++j) v[j] = *(const f32x4*)(lf + i0 + 4 * j);
    } else {
#pragma unroll
        for (int j = 0; j < 4; ++j) v[j] = (f32x4){0.f, 0.f, 0.f, 0.f};
    }
#pragma unroll
    for (int j = 0; j < 4; ++j) { v[j][0] += tot; v[j][1] += v[j][0]; v[j][2] += v[j][1]; v[j][3] += v[j][2]; tot = v[j][3]; }
    float inc = tot;
#pragma unroll
    for (int o = 1; o < 64; o <<= 1) { const float t = __shfl_up(inc, o); if (lane >= o) inc += t; }
    if (lane == 63) scan[wid] = inc;
    __syncthreads();
    float base = inc - tot;
    for (int w = 0; w < wid; ++w) base += scan[w];
    if (i0 < n) {
#pragma unroll
        for (int j = 0; j < 4; ++j) { f32x4 o4; o4[0] = -(v[j][0] + base) * LOG2E; o4[1] = -(v[j][1] + base) * LOG2E; o4[2] = -(v[j][2] + base) * LOG2E; o4[3] = -(v[j][3] + base) * LOG2E;
            *(LAS f32x4*)(cbt + i0 + 4 * j) = o4; }
    }
    __syncthreads();
}
#undef SBAR
}

#define XB_TMO      128
#define XB_XCNT(j)  (256  + 64 * (j))
#define XB_XSUB(j)  (1280 + 64 * (j))
#define XB_XGEN(j)  (2304 + 64 * (j))
#define XB_TOP      3328
#define XB_TOPGEN   3392
#define XCD_BAR_WORDS 3456
#define XB_SPIN_CAP (1u << 18)

__device__ __forceinline__ unsigned xb_ld(unsigned* p)              { return __hip_atomic_load(p, __ATOMIC_RELAXED, __HIP_MEMORY_SCOPE_AGENT); }
__device__ __forceinline__ unsigned xb_add(unsigned* p, unsigned v) { return __hip_atomic_fetch_add(p, v, __ATOMIC_RELAXED, __HIP_MEMORY_SCOPE_AGENT); }
__device__ __forceinline__ unsigned xb_xcc_id() { return (unsigned)__builtin_amdgcn_s_getreg((3 << 11) | 20) & 0xFu; }
#define XB_SPIN(cond, bar) do { unsigned _sp = 0; while (cond) { __builtin_amdgcn_s_sleep(1); \
    if ((++_sp & 255u) == 0u) { if (xb_ld(&(bar)[XB_TMO])) break; if (_sp > XB_SPIN_CAP) { atomicAdd(&(bar)[XB_TMO], 1u); break; } } } } while (0)

struct XcdBarrier {
    unsigned* bar; unsigned x;
    volatile LAS unsigned* st;
};

__device__ __forceinline__ XcdBarrier xcd_barrier_post(unsigned* bar, volatile LAS unsigned* st) {
    XcdBarrier b; b.bar = bar; b.x = xb_xcc_id(); b.st = st;
    if (threadIdx.x == 0) (void)xb_add(&bar[XB_XCNT(b.x)], 1u);
    return b;
}
__device__ __forceinline__ void xcd_barrier_complete(unsigned* bar, unsigned x, unsigned& nloc, unsigned& nx) {
    const unsigned G = gridDim.x * gridDim.y * gridDim.z;
    unsigned sum, cnt, mine, sp = 0u;
    for (;;) {
        sum = 0u; cnt = 0u; mine = 0u;
#pragma unroll
        for (unsigned j = 0; j < 16; ++j) { const unsigned c = xb_ld(&bar[XB_XCNT(j)]); sum += c; cnt += (c > 0u) ? 1u : 0u; mine = (j == x) ? c : mine; }
        if (sum == G) break;
        __builtin_amdgcn_s_sleep(1);
        if ((++sp & 255u) == 0u) { if (xb_ld(&bar[XB_TMO])) break; if (sp > XB_SPIN_CAP) { atomicAdd(&bar[XB_TMO], 1u); break; } }
    }
    nloc = mine > 0u ? mine : 1u; nx = cnt > 0u ? cnt : 1u;
}

__device__ __forceinline__ void xcd_barrier(const XcdBarrier& b) {
    asm volatile("s_waitcnt vmcnt(0)" ::: "memory");
    __syncthreads();
    if (threadIdx.x == 0) {
        unsigned* bar = b.bar;
        __builtin_amdgcn_s_waitcnt(0);
        unsigned nloc = b.st[0], nx = b.st[1];
        if (nloc == 0u) { xcd_barrier_complete(bar, b.x, nloc, nx); b.st[0] = nloc; b.st[1] = nx; }
        const unsigned old = xb_add(&bar[XB_XSUB(b.x)], 1u);
        const unsigned gen = old / nloc;
        if (old + 1u == (gen + 1u) * nloc) {
            __builtin_amdgcn_fence(__ATOMIC_RELEASE, "agent");
            asm volatile("s_waitcnt vmcnt(0)" ::: "memory");
            const unsigned og = xb_add(&bar[XB_TOP], 1u);
            const unsigned tg = og / nx;
            if (og + 1u == (tg + 1u) * nx) xb_add(&bar[XB_TOPGEN], 1u);
            else XB_SPIN(xb_ld(&bar[XB_TOPGEN]) == tg, bar);
            __builtin_amdgcn_fence(__ATOMIC_ACQUIRE, "agent");
            xb_add(&bar[XB_XGEN(b.x)], 1u);
            asm volatile("s_waitcnt vmcnt(0)" ::: "memory");
        } else {
            XB_SPIN(xb_ld(&bar[XB_XGEN(b.x)]) == gen, bar);
            __builtin_amdgcn_fence(__ATOMIC_ACQUIRE, "agent");
            asm volatile("s_waitcnt vmcnt(0)" ::: "memory");
        }
    }
    __syncthreads();
}

struct Args { const float* in[18]; float* out; unsigned char* ws; int ph_lo, ph_hi; };

__constant__ float c_invfreq[16] = {1.000000000e+00f, 4.403665960e-01f, 1.939227432e-01f, 8.539710194e-02f, 3.760603070e-02f, 1.656043902e-02f, 7.292664610e-03f, 3.211445874e-03f,
                                    1.414213562e-03f, 6.227723788e-04f, 2.742481884e-04f, 1.207697351e-04f, 5.318296098e-05f, 2.341999971e-05f, 1.031338616e-05f, 4.541670478e-06f};

__device__ __forceinline__ int rowmap(int mode, int n, int row_off) {
    if (mode == 0) return n + row_off;
    if (mode == 1) return (n >> 7) * 256 + (n & 127);
    if (mode == 2) return (n >> 7) * 256 + 128 + (n & 127);
    if (n < 6144) { const int seg = n >> 10, d = n & 127; if (seg < 2 && d < 32) { const int dn = d < 16 ? 2 * d : 2 * (d - 16) + 1; return n - d + dn; } return n; }
    if (n < 6152) return 10240 + (n - 6144);
    if (n < 8200) return 6144 + (n - 6152);
    return 8192 + (n - 8200);
}
struct CvtDesc { const float* W; int K, N; bf16_t* WT; int ldk, kofs, mode; const float* gain; int item; };
__device__ __forceinline__ void cvt_load(const CvtDesc& d, float (&v)[32], int lane) {
    const int nblk = (d.N + 31) / 32, kb = d.item / nblk, nb = d.item - kb * nblk, k0 = 64 * kb, n0 = 32 * nb;
    const int nn = n0 + (lane & 31); const bool ok = nn < d.N;
    const float* p = d.W + (size_t)(k0 + (lane >> 5)) * d.N + nn;
#pragma unroll
    for (int i = 0; i < 32; ++i) v[i] = ok ? p[(size_t)(2 * i) * d.N] : 0.f;
}
__device__ __forceinline__ void cvt_store(const CvtDesc& d, const float (&v)[32], LAS float* scr, int lane) {
    const int nblk = (d.N + 31) / 32, kb = d.item / nblk, nb = d.item - kb * nblk, k0 = 64 * kb, n0 = 32 * nb;
#pragma unroll
    for (int i = 0; i < 32; ++i) scr[(2 * i + (lane >> 5)) * 33 + (lane & 31)] = v[i];
    asm volatile("s_waitcnt lgkmcnt(0)" ::: "memory");
    const int c = lane & 7;
    f32x4 g0 = {1.f, 1.f, 1.f, 1.f}, g1 = {1.f, 1.f, 1.f, 1.f};
    if (d.gain) { g0 = *(const f32x4*)(d.gain + k0 + 8 * c); g1 = *(const f32x4*)(d.gain + k0 + 8 * c + 4); }
#pragma unroll
    for (int j = 0; j < 4; ++j) { const int n = (lane >> 3) + 8 * j; const LAS float* s = scr + (8 * c) * 33 + n;
        u32x4 o; o.x = cvt_pk_bf16(s[0 * 33] * g0[0], s[1 * 33] * g0[1]); o.y = cvt_pk_bf16(s[2 * 33] * g0[2], s[3 * 33] * g0[3]);
        o.z = cvt_pk_bf16(s[4 * 33] * g1[0], s[5 * 33] * g1[1]); o.w = cvt_pk_bf16(s[6 * 33] * g1[2], s[7 * 33] * g1[3]);
        if (n0 + n < d.N) *(u32x4*)(d.WT + (size_t)rowmap(d.mode, n0 + n, 0) * d.ldk + d.kofs + k0 + 8 * c) = o; }
    asm volatile("s_waitcnt lgkmcnt(0)" ::: "memory");
}
struct CvtTab { const float* in[18]; bf16_t *Wgu, *Wd, *Win, *Wp, *Wout; };
constexpr int CI_G = (DM / 64) * (FF / 32), CI_D = (FF / 64) * (DM / 32), CI_IN = (DM / 64) * ((INC + 31) / 32), CI_P = (1024 / 64) * (DM / 32), CI_O = (DM / 64) * (DM / 32);
constexpr int CVT_N0 = 2 * CI_G + CI_D + CI_IN + 2 * CI_P + CI_O;
constexpr int CVT_N1 = 2 * CI_G + CI_D;
__device__ __forceinline__ CvtDesc cvt_decode(const CvtTab& t, int list, int it) {
    CvtDesc d; int r = it; const int fb = list == 0 ? 2 : 14; const float* gn = t.in[list == 0 ? 1 : 13];
    if (r < CI_G) { d = CvtDesc{t.in[fb], DM, FF, t.Wgu, DM, 0, 1, gn, r}; return d; } r -= CI_G;
    if (r < CI_G) { d = CvtDesc{t.in[fb + 1], DM, FF, t.Wgu, DM, 0, 2, gn, r}; return d; } r -= CI_G;
    if (r < CI_D) { d = CvtDesc{t.in[fb + 2], FF, DM, t.Wd, FF, 0, 0, nullptr, r}; return d; } r -= CI_D;
    if (r < CI_IN) { d = CvtDesc{t.in[6], DM, INC, t.Win, DM, 0, 3, t.in[5], r}; return d; } r -= CI_IN;
    if (r < CI_P) { d = CvtDesc{t.in[10], 1024, DM, t.Wp, DM, 0, 0, nullptr, r}; return d; } r -= CI_P;
    if (r < CI_P) { d = CvtDesc{t.in[11], 1024, DM, t.Wp, DM, 1024, 0, nullptr, r}; return d; } r -= CI_P;
    d = CvtDesc{t.in[12], DM, DM, t.Wout, DM, 0, 0, nullptr, r}; return d;
}
__device__ __forceinline__ void convert_list(const CvtTab& t, int list, int nitems, LAS float* scr, int gw, int NGW, int lane) {
    float va[32], vb[32];
    int it = gw;
    CvtDesc da, db;
    if (it < nitems) { da = cvt_decode(t, list, it); cvt_load(da, va, lane); }
    while (it < nitems) {
        const int it2 = it + NGW;
        if (it2 < nitems) { db = cvt_decode(t, list, it2); cvt_load(db, vb, lane); }
        cvt_store(da, va, scr, lane);
        const int it3 = it2 + NGW;
        if (it3 < nitems) { da = cvt_decode(t, list, it3); cvt_load(da, va, lane); }
        if (it2 < nitems) cvt_store(db, vb, scr, lane);
        it = it3;
    }
}

#ifndef MK_LAUNCHES
#define MK_LAUNCHES 1
#endif
constexpr int LDS_BYTES = 147456;

__global__ void __launch_bounds__(512, 2) fwd_megakernel(Args a) {
    extern __shared__ __attribute__((aligned(16))) unsigned char lds_raw[];
#if MK_LAUNCHES == 1
    cg::grid_group grid = cg::this_grid();
#endif
    LAS unsigned char* lds = (LAS unsigned char*)lds_raw;

#if MK_LAUNCHES == 1
    { volatile LAS unsigned* st0 = (volatile LAS unsigned*)(lds + LDS_BYTES - 64); if (threadIdx.x < 16) st0[threadIdx.x] = 0u; }
    __syncthreads();
    const XcdBarrier xbar = xcd_barrier_post((unsigned*)(a.ws + WS_BAR), (volatile LAS unsigned*)(lds + LDS_BYTES - 64));
#define GSYNC() xcd_barrier(xbar)
#define IN(k) true
    grid.sync();
#else
#define GSYNC() do { } while (0)
#define IN(k) (a.ph_lo == (k))
#endif
#define PHASE_IDS int tid_ = threadIdx.x; asm volatile("" : "+v"(tid_)); const int tid = tid_, lane = tid & 63, wave = __builtin_amdgcn_readfirstlane(tid >> 6); \
    const int gw = vcu * 8 + wave, NGW = G * 8, gt = vcu * 512 + tid, NGT = G * 512; LAS float* scr = (LAS float*)(lds + wave * 16384); (void)gw; (void)NGW; (void)gt; (void)NGT; (void)scr; (void)lane;
    const int G = gridDim.x, bx = blockIdx.x;
    const int vcu = (G % 8 == 0) ? (bx % 8) * (G / 8) + bx / 8 : bx;
    unsigned char* ws = a.ws;
    float* ssq0 = (float*)(ws + WS_SSQ); float* ssq1 = ssq0 + T; float* ssq2 = ssq1 + T; float* ssq3 = ssq2 + T;
    float* rope = (float*)(ws + WS_ROPE); float* logf = (float*)(ws + WS_LOGF);
    bf16_t* Wgu = (bf16_t*)(ws + WS_WGU); bf16_t* Wd = (bf16_t*)(ws + WS_WD); bf16_t* Win = (bf16_t*)(ws + WS_WIN);
    bf16_t* Wp = (bf16_t*)(ws + WS_WP); bf16_t* Wout = (bf16_t*)(ws + WS_WOUT);
    bf16_t* xb = (bf16_t*)(ws + WS_XB); bf16_t* act = (bf16_t*)(ws + WS_BIG); bf16_t* qkv = (bf16_t*)(ws + WS_BIG); bf16_t* merged = (bf16_t*)(ws + WS_BIG);
    bf16_t* gates = (bf16_t*)(ws + WS_GATES);
    const float* x = a.in[0]; float* out = a.out;

    if (IN(0))
    {
        PHASE_IDS
#ifndef REP0
#define REP0 1
#endif
        for (int rep0 = 0; rep0 < REP0; ++rep0) {
        { CvtTab ct; for (int i = 0; i < 18; ++i) ct.in[i] = a.in[i]; ct.Wgu = Wgu; ct.Wd = Wd; ct.Win = Win; ct.Wp = Wp; ct.Wout = Wout;
          convert_list(ct, 0, CVT_N0, scr, gw, NGW, lane); }
#ifdef DIAG_POISON
        { const u32x4 pz = {0xAAAAAAAAu, 0xAAAAAAAAu, 0xAAAAAAAAu, 0xAAAAAAAAu};
          for (size_t i = gt; i < (WS_END - WS_BIG) / 16; i += NGT) *(u32x4*)(ws + WS_BIG + i * 16) = pz;
          for (size_t i = gt; i < (512 * 1024) / 16; i += NGT) *(u32x4*)(ws + WS_LOGF + i * 16) = pz;
          for (size_t i = gt; i < ((size_t)T * DM * 4) / 16; i += NGT) *(u32x4*)((unsigned char*)out + i * 16) = pz; }
#endif
        for (int i = gt; i < (NIN - INC) * DM / 8; i += NGT) *(u32x4*)(Win + (size_t)INC * DM + (size_t)i * 8) = (u32x4){0u, 0u, 0u, 0u};
        for (int i = gt; i < 3 * T; i += NGT) ssq1[i] = 0.f;
        for (int i = gt; i < SEQ * 16; i += NGT) { const int pos = i >> 4, f = i & 15; const float ang = (float)pos * c_invfreq[f];
            double rev = (double)ang * 0.15915494309189535; rev -= __builtin_rint(rev); const float fr = (float)rev;
            rope[2 * i] = __builtin_amdgcn_cosf(fr); rope[2 * i + 1] = __builtin_amdgcn_sinf(fr); }
        for (int m = gw; m < T; m += NGW) { const f32x4* xr = (const f32x4*)(x + (size_t)m * DM) + lane; float s = 0.f;
            u32x2* o8 = (u32x2*)(xb + (size_t)m * DM) + lane;
#pragma unroll
            for (int j = 0; j < 8; ++j) { const f32x4 v = xr[64 * j]; s += (v[0] * v[0] + v[1] * v[1]) + (v[2] * v[2] + v[3] * v[3]);
                u32x2 w; w.x = cvt_pk_bf16(v[0], v[1]); w.y = cvt_pk_bf16(v[2], v[3]); o8[64 * j] = w; }
            s = wave_sum(s); if (lane == 0) ssq0[m] = s; }
        asm volatile("" ::: "memory"); }
    }
    GSYNC();
    if (IN(1))
    { pg8::Gemm g{xb, Wgu, DM, DM, DM}; pg8::StaticOrder S; S.init(T, NGU, G, bx); pg8::EpiSwiGLU E{act, ssq0}; pg8::gemm_phase(lds, g, S, E); }
    GSYNC();
    if (IN(2))
    { pg8::Gemm g{act, Wd, FF, FF, FF}; pg8::StaticOrder S; S.init(T, DM, G, bx); pg8::EpiResid E{x, out, xb, ssq1, 0.5f}; pg8::gemm_phase(lds, g, S, E); }
    GSYNC();
    if (IN(3))
    { pg8::Gemm g{xb, Win, DM, DM, DM}; pg8::StaticOrder S; S.init(T, 10240, G, bx); pg8::EpiWin E{qkv, gates, logf, ssq1, rope, a.in[7], a.in[8], a.in[9]}; pg8::gemm_phase(lds, g, S, E); }
    if (IN(3))
    {
        PHASE_IDS
        const bf16_t* Wf = Win + (size_t)10240 * DM; const float* b_forget = a.in[7];
        for (int m = gw; m < T; m += NGW) {
            const u32x4* xr = (const u32x4*)(xb + (size_t)m * DM) + lane; u32x4 xv[4];
#pragma unroll
            for (int j = 0; j < 4; ++j) xv[j] = xr[64 * j];
            float accf[8];
#pragma unroll
            for (int h = 0; h < 8; ++h) { const u32x4* wr_ = (const u32x4*)(Wf + (size_t)h * DM) + lane; float sacc = 0.f;
#pragma unroll
                for (int j = 0; j < 4; ++j) { const u32x4 wv = wr_[64 * j];
                    sacc += bf_lo(xv[j].x) * bf_lo(wv.x) + bf_hi(xv[j].x) * bf_hi(wv.x) + bf_lo(xv[j].y) * bf_lo(wv.y) + bf_hi(xv[j].y) * bf_hi(wv.y)
                          + bf_lo(xv[j].z) * bf_lo(wv.z) + bf_hi(xv[j].z) * bf_hi(wv.z) + bf_lo(xv[j].w) * bf_lo(wv.w) + bf_hi(xv[j].w) * bf_hi(wv.w); }
                accf[h] = wave_sum(sacc); }
            if (lane < 8) { float v = accf[0];
#pragma unroll
                for (int h = 1; h < 8; ++h) v = (lane == h) ? accf[h] : v;
                const float z = v * pg8::rstd_of(ssq1, m) + b_forget[lane];
                const float ls = fminf(z, 0.f) - __logf(1.f + __expf(-fabsf(z)));
                logf[(size_t)((m >> 13) * NH + lane) * SEQ + (m & (SEQ - 1))] = ls; }
        }
    }
    GSYNC();
    if (IN(4))
    {
        using namespace att;
        PHASE_IDS
        char* al = (char*)lds_raw;
        LAS float* cbt = (LAS float*)(lds + LDS_CB); LAS float* dtab = (LAS float*)(lds + LDS_DT); LAS float* scan = (LAS float*)(lds + LDS_SCAN);
        for (int i = tid; i < DT_N; i += 512) { const int dl = i - DT_OFF; float v = -__builtin_inff();
            if (dl >= 0 && dl <= 2048) { const int mlt = (dl <= 128 ? 1 : 0) + (((dl & 3) == 0 && dl <= 512) ? 1 : 0) + (((dl & 15) == 0) ? 1 : 0);
                v = mlt == 0 ? -__builtin_inff() : (mlt == 1 ? 0.f : (mlt == 2 ? 1.f : 1.5849625007211562f)); }
            dtab[i] = v; }
        __syncthreads();
        constexpr int NFOX = 256, NDIL = 256, TOTAL = NFOX + NDIL;
        const bf16* qkvb = (const bf16*)qkv; bf16* ycat = (bf16*)xb;
        struct Item { int mode, bh, qb0, qb1; };
        auto decode = [&](int L) { Item it; const unsigned long long FA = 0x5432DB910AFEC876ull;
            if (L < NFOX) { it.mode = 0; it.bh = L >> 4; const int sl = L & 15; it.qb0 = (int)((FA >> (4 * sl)) & 15);
                const int sums = sl < 8 ? 37 - sl : (sl < 12 ? 29 : 28); it.qb1 = sums - it.qb0; }
            else { const int l2 = L - NFOX; it.mode = 1; it.bh = l2 >> 4; const int sl = l2 & 15; if (sl < 8) { it.qb0 = sl; it.qb1 = 8 + sl; } else { it.qb0 = 2 * sl; it.qb1 = 2 * sl + 1; } }
            return it; };
        auto mkref = [&](const Item& it, int pass) { const int qb = pass ? it.qb1 : it.qb0; BlockRef r; const size_t seg = (size_t)T * 1024; const int sb = it.mode == 0 ? 3 : 0;
            const size_t hb = (size_t)it.bh * SEQ * HD;
            r.Q = qkvb + (sb + 0) * seg + hb + (size_t)qb * QB * HD; r.K = qkvb + (sb + 1) * seg + hb; r.V = qkvb + (sb + 2) * seg + hb;
            r.O = ycat + ((size_t)(it.bh >> 3) * SEQ + (size_t)qb * QB) * LDO + (it.mode == 0 ? 1024 : 0) + (it.bh & 7) * HD; r.P0 = qb * QB; r.W = it.mode == 0 ? (1 << 30) : 2049;
            return r; };
#define ATT_STREAM(MODE_, LBEG, LEND) do { int L = (LBEG) + vcu; if (L < (LEND)) { \
            Item it = decode(L); int pass = 0; BlockRef cur = mkref(it, 0); Seam S; \
            attn_prime<MODE_>(cur, al, S); \
            for (;;) { \
                const bool more_pass = pass == 0 && it.qb1 != it.qb0, more_item = L + G < (LEND), last = !more_pass && !more_item; \
                Item itn = it; int passn = pass + 1, Ln = L; \
                if (!more_pass) { passn = 0; Ln = more_item ? L + G : L; itn = decode(Ln); } \
                const BlockRef nxt = last ? cur : mkref(itn, passn); \
                if (MODE_ == 0 && pass == 0) { const int mq = it.qb0 > it.qb1 ? it.qb0 : it.qb1; build_cb(logf + (size_t)it.bh * SEQ, (mq + 1) * QB, cbt, scan, tid); } \
                attn_block<MODE_>(cur, nxt, al, cbt, dtab, S); \
                if (last) break; \
                cur = nxt; it = itn; pass = passn; L = Ln; \
            } } } while (0)
#ifndef REP4
#define REP4 1
#endif
        for (int rep4 = 0; rep4 < REP4; ++rep4) {
        ATT_STREAM(0, 0, NFOX);
        __syncthreads();
        ATT_STREAM(1, NFOX, TOTAL);
        __syncthreads(); }
#undef ATT_STREAM
    }
    GSYNC();
    if (IN(5))
    {
        PHASE_IDS
        { CvtTab ct; for (int i = 0; i < 18; ++i) ct.in[i] = a.in[i]; ct.Wgu = Wgu; ct.Wd = Wd; ct.Win = Win; ct.Wp = Wp; ct.Wout = Wout;
          convert_list(ct, 1, CVT_N1, scr, gw, NGW, lane); }
        __syncthreads();
        pg8::Gemm g{xb, Wp, 1024, DM, DM}; pg8::StaticOrder S; S.init(T, DM, G, bx, 2); pg8::EpiProj E{gates, merged}; pg8::gemm_phase(lds, g, S, E);
    }
    GSYNC();
    if (IN(6))
    { pg8::Gemm g{merged, Wout, DM, DM, DM}; pg8::StaticOrder S; S.init(T, DM, G, bx); pg8::EpiResid E{out, out, xb, ssq2, 1.0f}; pg8::gemm_phase(lds, g, S, E); }
    GSYNC();
    if (IN(7))
    { pg8::Gemm g{xb, Wgu, DM, DM, DM}; pg8::StaticOrder S; S.init(T, NGU, G, bx); pg8::EpiSwiGLU E{act, ssq2}; pg8::gemm_phase(lds, g, S, E); }
    GSYNC();
    if (IN(8))
    { pg8::Gemm g{act, Wd, FF, FF, FF}; pg8::StaticOrder S; S.init(T, DM, G, bx); pg8::EpiResid E{out, out, nullptr, ssq3, 0.5f}; pg8::gemm_phase(lds, g, S, E); }
    GSYNC();
    if (IN(9))
    {
        PHASE_IDS
        const float* fn = a.in[17];
        for (int m = gw; m < T; m += NGW) { f32x4* xr = (f32x4*)(out + (size_t)m * DM) + lane; const float rs = rsqrtf(ssq3[m] * (1.f / (float)DM) + EPS);
#pragma unroll
            for (int j = 0; j < 8; ++j) { const f32x4 gg = *((const f32x4*)fn + lane + 64 * j); f32x4 v = xr[64 * j]; v = v * rs * gg; xr[64 * j] = v; } }
    }
}

extern "C" void kernel_launch(void* const* d_in, const int* in_sizes, int n_in, void* d_out, int out_size, void* d_ws, size_t ws_size, hipStream_t stream) {
    static int grid = 0;
    if (grid == 0) {
        if (n_in != 18 || out_size != T * DM || ws_size < WS_END) { fprintf(stderr, "kernel_launch: unexpected shapes n_in %d out %d ws %zu\n", n_in, out_size, ws_size); grid = -1; return; }
        int dev = 0, cus = 0, per_cu = 0;
        (void)hipGetDevice(&dev); (void)hipDeviceGetAttribute(&cus, hipDeviceAttributeMultiprocessorCount, dev);
        if (hipFuncSetAttribute((const void*)fwd_megakernel, hipFuncAttributeMaxDynamicSharedMemorySize, LDS_BYTES) != hipSuccess) { fprintf(stderr, "hipFuncSetAttribute failed\n"); grid = -1; return; }
        if (hipOccupancyMaxActiveBlocksPerMultiprocessor(&per_cu, (const void*)fwd_megakernel, 512, LDS_BYTES) != hipSuccess || per_cu < 1) { fprintf(stderr, "occupancy query: %d\n", per_cu); per_cu = 1; }
        (void)hipGetLastError();
        grid = cus * per_cu;
        fprintf(stderr, "kernel_launch: grid %d (cus %d x %d)\n", grid, cus, per_cu);
    }
    if (grid < 0) return;
    (void)hipMemsetAsync((char*)d_ws + WS_BAR, 0, XCD_BAR_WORDS * 4, stream);
    Args a{};
    for (int i = 0; i < 18; ++i) a.in[i] = (const float*)d_in[i];
    a.out = (float*)d_out; a.ws = (unsigned char*)d_ws;
#if MK_LAUNCHES == 1
    a.ph_lo = 0; a.ph_hi = 10;
    void* args[] = {&a};
    hipError_t e = hipLaunchCooperativeKernel((const void*)fwd_megakernel, dim3(grid), dim3(512), args, LDS_BYTES, stream);
    if (e != hipSuccess) fprintf(stderr, "cooperative launch failed: %s (grid %d)\n", hipGetErrorString(e), grid);
#else
    for (int k = 0; k < 10; ++k) { a.ph_lo = k; a.ph_hi = k + 1; hipLaunchKernelGGL(fwd_megakernel, dim3(grid), dim3(512), LDS_BYTES, stream, a); }
#endif
}
```

```cpp
#include <hip/hip_runtime.h>
#include <hip/hip_bf16.h>
#include <hip/hip_cooperative_groups.h>
#include <cstdio>
#include <cstdint>
namespace cg = cooperative_groups;

#define LAS __attribute__((address_space(3)))
typedef unsigned short bf16_t;
typedef short bf16x8 __attribute__((ext_vector_type(8)));
typedef short s16x4 __attribute__((ext_vector_type(4)));
typedef float f32x4 __attribute__((ext_vector_type(4)));
typedef float f32x16 __attribute__((ext_vector_type(16)));
typedef unsigned u32x4 __attribute__((ext_vector_type(4)));
typedef unsigned u32x2 __attribute__((ext_vector_type(2)));

constexpr int T = 16384, SEQ = 8192, DM = 2048, FF = 5632, NH = 8, HD = 128;
constexpr int NGU = 2 * FF;
constexpr int NIN = 10496;
constexpr int INC = 10248;
constexpr float EPS = 1e-6f;
constexpr float LOG2E = 1.4426950408889634f;
constexpr float QSCALE = 0.08838834764831845f * LOG2E;

constexpr size_t MiB = 1u << 20;
constexpr size_t WS_SSQ = 0;
constexpr size_t WS_BAR = 512 * 1024;
constexpr size_t WS_ROPE = 1 * MiB;
constexpr size_t WS_LOGF = 2 * MiB;
constexpr size_t WS_WGU = 3 * MiB;
constexpr size_t WS_WD = 47 * MiB;
constexpr size_t WS_WIN = 69 * MiB;
constexpr size_t WS_WP = 110 * MiB;
constexpr size_t WS_WOUT = 118 * MiB;
constexpr size_t WS_XB = 126 * MiB;
constexpr size_t WS_BIG = 190 * MiB;
constexpr size_t WS_GATES = 382 * MiB;
constexpr size_t WS_END = 510 * MiB;

typedef float f32x2_t __attribute__((ext_vector_type(2))); typedef __bf16 bf16x2_t __attribute__((ext_vector_type(2)));
__device__ __forceinline__ unsigned cvt_pk_bf16(float lo, float hi) { f32x2_t v = {lo, hi}; bf16x2_t b = __builtin_convertvector(v, bf16x2_t); return __builtin_bit_cast(unsigned, b); }
__device__ __forceinline__ float bf_lo(unsigned w) { return __uint_as_float(w << 16); }
__device__ __forceinline__ float bf_hi(unsigned w) { return __uint_as_float(w & 0xffff0000u); }
__device__ __forceinline__ float wave_sum(float v) {
#pragma unroll
    for (int o = 1; o < 64; o <<= 1) v += __shfl_xor(v, o);
    return v;
}

namespace pg8 {
constexpr int BM = 256, BK = 64, HALF = 128, HTB = HALF * BK * 2, STAGE_BYTES = 8 * HTB, NXCD = 8, WGM = 8;
__host__ __device__ __forceinline__ int lds_byte(int r, int c) { const int st = (r >> 4) * 2 + (c >> 5), rr = r & 15, cc = c & 31, ob = rr * 64 + cc * 2; return st * 1024 + (ob ^ (((ob >> 9) & 1) << 5)); }
__host__ __device__ __forceinline__ void stage_rc(int b, int& R, int& C) { const int st = b / 1024, sb = b % 1024, swz = sb ^ (((sb >> 9) & 1) << 5); R = (st >> 1) * 16 + swz / 64; C = (st & 1) * 32 + (swz % 64) / 2; }
__host__ __device__ __forceinline__ int perm32(int rho) { const int n = rho >> 4, i = rho & 15; return 8 * (i >> 2) + 4 * n + (i & 3); }

struct Unit { int pm, pn, ko, half; };
struct Gemm { const bf16_t* A; const bf16_t* Bt; int K, lda, ldb; };

struct StaticOrder {
    int nM, nN, nwg, G, c, halves;
    __device__ void init(int M, int N, int G_, int c_, int halves_ = 1) { nM = M / BM; nN = N / BM; nwg = nM * nN; G = G_; c = c_; halves = halves_; }
    __device__ bool next(int i, Unit& u) const {
        const int it = i / halves, hf = i - it * halves;
        const long L = (long)it * G + c; if (L >= nwg) return false;
        int wgid = (int)L; { const int q = nwg / NXCD, r = nwg % NXCD, xcd = wgid % NXCD, off = wgid / NXCD; wgid = (xcd < r ? xcd * (q + 1) : r * (q + 1) + (xcd - r) * q) + off; }
        const int nig = WGM * nN, gid = wgid / nig, fm = gid * WGM, gsz = (nM - fm) < WGM ? (nM - fm) : WGM;
        u.pm = fm + ((wgid % nig) % gsz); u.pn = (wgid % nig) / gsz; u.half = hf; u.ko = hf * 1024; return true;
    }
};

template <class Epi, class Sched>
__device__ __forceinline__ void gemm_phase(LAS unsigned char* lds, const Gemm g, const Sched& S, const Epi& E) {
    int tid_ = threadIdx.x; asm volatile("" : "+v"(tid_));
    const int tid = tid_, wid = __builtin_amdgcn_readfirstlane(tid >> 6), lane = tid & 63, wr = wid >> 2, wc = wid & 3, fr = lane & 15, fq = lane >> 4;
    const int nt = g.K / BK;
    unsigned voffA[2], voffB[2];
#pragma unroll
    for (int i = 0; i < 2; ++i) { int R, C; stage_rc(tid * 16 + i * 8192, R, C); const int Rb = (R & ~31) + perm32(R & 31);
        voffA[i] = (unsigned)(R * g.lda + C) * 2u; voffB[i] = (unsigned)(Rb * g.ldb + C) * 2u; }
    const size_t kstep = (size_t)(BK * 2);
    const size_t hstepA = (size_t)HALF * g.lda * 2, hstepB = (size_t)HALF * g.ldb * 2;
    const size_t tstepA = 2 * hstepA, tstepB = 2 * hstepB;
    const unsigned ldsw = (unsigned)wid * 1024u;
    const int aoff = lds_byte(wr * 64 + fr, fq * 8), boff = lds_byte(wc * 32 + fr, fq * 8);
#define PG8_SA(b, h) (((b) * 2 + (h)) * HTB)
#define PG8_SB(b, h) ((4 + (b) * 2 + (h)) * HTB)
#define PG8_STAGE(bufoff, gbase, voff) do { _Pragma("unroll") for (int _i = 0; _i < 2; ++_i) \
        __builtin_amdgcn_global_load_lds((const unsigned*)((const char*)(gbase) + (voff)[_i]), (LAS unsigned*)(lds + (bufoff) + ldsw + _i * 8192), 16, 0, 0); } while (0)
#define PG8_LDA(dst, b, h) do { _Pragma("unroll") for (int m = 0; m < 4; ++m) _Pragma("unroll") for (int k = 0; k < 2; ++k) dst[m][k] = *(const LAS bf16x8*)(lds + PG8_SA(b, h) + aoff + m * 2048 + k * 1024); } while (0)
#define PG8_LDB(dst, b, h) do { _Pragma("unroll") for (int n = 0; n < 2; ++n) _Pragma("unroll") for (int k = 0; k < 2; ++k) dst[n][k] = *(const LAS bf16x8*)(lds + PG8_SB(b, h) + boff + n * 2048 + k * 1024); } while (0)
#define PG8_MMA(ai, bj, At, Bt) do { __builtin_amdgcn_s_setprio(1); _Pragma("unroll") for (int m = 0; m < 4; ++m) _Pragma("unroll") for (int n = 0; n < 2; ++n) _Pragma("unroll") for (int k = 0; k < 2; ++k) \
        acc[ai][bj][m][n] = __builtin_amdgcn_mfma_f32_16x16x32_bf16(Bt[n][k], At[m][k], acc[ai][bj][m][n], 0, 0, 0); __builtin_amdgcn_s_setprio(0); } while (0)
#define PG8_WAIT_V(n) asm volatile("s_waitcnt vmcnt(" #n ")" ::: "memory")
#define PG8_WAIT_L(n) asm volatile("s_waitcnt lgkmcnt(" #n ")" ::: "memory")
#define PG8_BAR __builtin_amdgcn_s_barrier()
#define PG8_SCHED __builtin_amdgcn_sched_barrier(0)
    Unit cur, nxt; int ui = 0;
    if (!S.next(0, cur)) return;
    constexpr int RELAX = (8 + Epi::STORES) > 63 ? 63 : (8 + Epi::STORES);
#define PG8_WAIT_V8F do { if (Epi::STORES > 0 && t == 0) asm volatile("s_waitcnt vmcnt(%0)" :: "i"(RELAX) : "memory"); else asm volatile("s_waitcnt vmcnt(8)" ::: "memory"); } while (0)
    f32x4 acc[2][2][4][2];
#pragma unroll
    for (int a = 0; a < 2; ++a)
#pragma unroll
        for (int b = 0; b < 2; ++b)
#pragma unroll
            for (int m = 0; m < 4; ++m)
#pragma unroll
                for (int n = 0; n < 2; ++n) acc[a][b][m][n] = (f32x4){0.f, 0.f, 0.f, 0.f};
    bf16x8 At[4][2], B0[2][2], B1[2][2];
    const char* cA = (const char*)g.A + (size_t)cur.pm * tstepA + (size_t)cur.ko * 2; const char* cB = (const char*)g.Bt + (size_t)cur.pn * tstepB + (size_t)cur.ko * 2;
    PG8_STAGE(PG8_SB(0, 0), cB, voffB); PG8_STAGE(PG8_SB(0, 1), cB + hstepB, voffB); PG8_STAGE(PG8_SA(0, 0), cA, voffA); PG8_STAGE(PG8_SA(0, 1), cA + hstepA, voffA);
    if (wr == 1) PG8_BAR;
    PG8_WAIT_V(2); PG8_BAR;
    PG8_STAGE(PG8_SB(1, 0), cB + kstep, voffB); PG8_STAGE(PG8_SA(1, 0), cA + kstep, voffA); PG8_STAGE(PG8_SB(1, 1), cB + hstepB + kstep, voffB);
    if (Epi::STORES > 0) { PG8_WAIT_V(0); } else { PG8_WAIT_V(6); } PG8_BAR;
    for (;;) {
        const bool has_next = S.next(ui + 1, nxt);
        const char* nA = has_next ? (const char*)g.A + (size_t)nxt.pm * tstepA + (size_t)nxt.ko * 2 : cA; const char* nB = has_next ? (const char*)g.Bt + (size_t)nxt.pn * tstepB + (size_t)nxt.ko * 2 : cB;
        for (int t = 0; t < nt; t += 2) {
            const bool last = (t == nt - 2);
            const char* a1 = cA + (size_t)(t + 1) * kstep;
            const char* a2 = last ? nA : cA + (size_t)(t + 2) * kstep; const char* b2 = last ? nB : cB + (size_t)(t + 2) * kstep;
            const char* a3 = a2 + kstep; const char* b3 = b2 + kstep;
            PG8_LDB(B0, 0, 0); PG8_LDB(B1, 0, 1); PG8_SCHED; PG8_LDA(At, 0, 0); PG8_STAGE(PG8_SA(1, 1), a1 + hstepA, voffA);
            PG8_WAIT_V8F; PG8_WAIT_L(0); PG8_BAR; PG8_MMA(0, 0, At, B0); PG8_MMA(0, 1, At, B1); PG8_BAR; PG8_SCHED;
            PG8_LDA(At, 0, 1); PG8_STAGE(PG8_SB(0, 0), b2, voffB); PG8_STAGE(PG8_SB(0, 1), b2 + hstepB, voffB); PG8_STAGE(PG8_SA(0, 0), a2, voffA);
            PG8_WAIT_V8F; PG8_WAIT_L(0); PG8_BAR; PG8_MMA(1, 0, At, B0); PG8_MMA(1, 1, At, B1); PG8_BAR; PG8_SCHED;
            PG8_LDB(B0, 1, 0); PG8_LDB(B1, 1, 1); PG8_SCHED; PG8_LDA(At, 1, 0); PG8_STAGE(PG8_SA(0, 1), a2 + hstepA, voffA);
            PG8_WAIT_V(8); PG8_WAIT_L(0); PG8_BAR; PG8_MMA(0, 0, At, B0); PG8_MMA(0, 1, At, B1); PG8_BAR; PG8_SCHED;
            PG8_LDA(At, 1, 1); PG8_STAGE(PG8_SB(1, 0), b3, voffB); PG8_STAGE(PG8_SB(1, 1), b3 + hstepB, voffB); PG8_STAGE(PG8_SA(1, 0), a3, voffA);
            PG8_WAIT_V(8); PG8_WAIT_L(0); PG8_BAR; PG8_MMA(1, 0, At, B0); PG8_MMA(1, 1, At, B1); PG8_BAR; PG8_SCHED;
        }
        if (wr == 0) PG8_BAR;
        E(acc, cur, wr, wc, fr, fq);
        if (!has_next) break;
#pragma unroll
        for (int a = 0; a < 2; ++a)
#pragma unroll
            for (int b = 0; b < 2; ++b)
#pragma unroll
                for (int m = 0; m < 4; ++m)
#pragma unroll
                    for (int n = 0; n < 2; ++n) acc[a][b][m][n] = (f32x4){0.f, 0.f, 0.f, 0.f};
        cur = nxt; cA = nA; cB = nB; ++ui;
        if (wr == 1) PG8_BAR;
    }
    PG8_WAIT_V(0);
    PG8_BAR;
#undef PG8_SA
#undef PG8_SB
#undef PG8_STAGE
#undef PG8_LDA
#undef PG8_LDB
#undef PG8_MMA
#undef PG8_WAIT_V
#undef PG8_WAIT_L
#undef PG8_BAR
#undef PG8_SCHED
}

typedef const f32x4 (&AccRef)[2][2][4][2];

__device__ __forceinline__ float rstd_of(const float* ssq, int r) { return rsqrtf(ssq[r] * (1.f / (float)DM) + EPS); }
__device__ __forceinline__ float silu_mul(float g, float u) { return g * __builtin_amdgcn_rcpf(1.f + __builtin_amdgcn_exp2f(-g * LOG2E)) * u; }
__device__ __forceinline__ float sigmoidf_(float z) { return __builtin_amdgcn_rcpf(1.f + __builtin_amdgcn_exp2f(-z * LOG2E)); }

struct EpiSwiGLU {
    static constexpr int STORES = 8;
    bf16_t* O; const float* ssq;
    __device__ __forceinline__ void operator()(AccRef acc, const Unit& u, int wr, int wc, int fr, int fq) const {
        const int row0 = u.pm * BM + wr * 64 + fr, col = u.pn * HALF + wc * 32 + 8 * fq;
        float rsv[8];
#pragma unroll
        for (int i = 0; i < 8; ++i) rsv[i] = ssq[row0 + (i >> 2) * HALF + (i & 3) * 16];
#pragma unroll
        for (int i = 0; i < 8; ++i) rsv[i] = rsqrtf(rsv[i] * (1.f / (float)DM) + EPS);
#pragma unroll
        for (int ai = 0; ai < 2; ++ai)
#pragma unroll
            for (int m = 0; m < 4; ++m) { const int r = row0 + ai * HALF + m * 16; const float rs = rsv[ai * 4 + m];
                const f32x4 g0 = acc[ai][0][m][0] * rs, g1 = acc[ai][0][m][1] * rs, u0 = acc[ai][1][m][0] * rs, u1 = acc[ai][1][m][1] * rs;
                u32x4 w; w.x = cvt_pk_bf16(silu_mul(g0[0], u0[0]), silu_mul(g0[1], u0[1])); w.y = cvt_pk_bf16(silu_mul(g0[2], u0[2]), silu_mul(g0[3], u0[3]));
                w.z = cvt_pk_bf16(silu_mul(g1[0], u1[0]), silu_mul(g1[1], u1[1])); w.w = cvt_pk_bf16(silu_mul(g1[2], u1[2]), silu_mul(g1[3], u1[3]));
                *(u32x4*)(O + (size_t)r * FF + col) = w; }
    }
};
struct EpiResid {
    static constexpr int STORES = 40;
    const float* resid; float* out; bf16_t* xb; float* ssq; float alpha;
    __device__ __forceinline__ void operator()(AccRef acc, const Unit& u, int wr, int wc, int fr, int fq) const {
        const int row0 = u.pm * BM + wr * 64 + fr, col0 = u.pn * BM + wc * 32 + 8 * fq;
        f32x4 cur[4], nxt[4];
        { const size_t off = (size_t)row0 * DM + col0; cur[0] = *(const f32x4*)(resid + off); cur[1] = *(const f32x4*)(resid + off + 4); cur[2] = *(const f32x4*)(resid + off + HALF); cur[3] = *(const f32x4*)(resid + off + HALF + 4); }
#pragma unroll
        for (int i = 0; i < 8; ++i) { const int ai = i >> 2, m = i & 3; const int r = row0 + ai * HALF + m * 16; float sq = 0.f;
            if (i < 7) { const int rn = row0 + ((i + 1) >> 2) * HALF + ((i + 1) & 3) * 16; const size_t off = (size_t)rn * DM + col0;
                nxt[0] = *(const f32x4*)(resid + off); nxt[1] = *(const f32x4*)(resid + off + 4); nxt[2] = *(const f32x4*)(resid + off + HALF); nxt[3] = *(const f32x4*)(resid + off + HALF + 4); }
            asm volatile("" ::: "memory");
#pragma unroll
            for (int bj = 0; bj < 2; ++bj) { const size_t off = (size_t)r * DM + col0 + bj * HALF;
                const f32x4 o0 = cur[2 * bj] + acc[ai][bj][m][0] * alpha, o1 = cur[2 * bj + 1] + acc[ai][bj][m][1] * alpha;
                *(f32x4*)(out + off) = o0; *(f32x4*)(out + off + 4) = o1;
                sq += (o0[0] * o0[0] + o0[1] * o0[1]) + (o0[2] * o0[2] + o0[3] * o0[3]) + (o1[0] * o1[0] + o1[1] * o1[1]) + (o1[2] * o1[2] + o1[3] * o1[3]);
                if (xb) { u32x4 w; w.x = cvt_pk_bf16(o0[0], o0[1]); w.y = cvt_pk_bf16(o0[2], o0[3]); w.z = cvt_pk_bf16(o1[0], o1[1]); w.w = cvt_pk_bf16(o1[2], o1[3]); *(u32x4*)(xb + off) = w; } }
            sq += __shfl_xor(sq, 16); sq += __shfl_xor(sq, 32);
            if (fq == 0) atomicAdd(ssq + r, sq);
#pragma unroll
            for (int k = 0; k < 4; ++k) cur[k] = nxt[k]; }
    }
};
struct EpiWin {
    static constexpr int STORES = 0;
    bf16_t* qkv; bf16_t* gates; float* logf; const float* ssq; const float* rope; const float* b_forget; const float* b_gd; const float* b_gf;
    __device__ __forceinline__ void operator()(AccRef acc, const Unit& u, int wr, int wc, int fr, int fq) const {
        const int row0 = u.pm * BM + wr * 64 + fr, pn = u.pn;
        float rsv[8];
#pragma unroll
        for (int i = 0; i < 8; ++i) rsv[i] = ssq[row0 + (i >> 2) * HALF + (i & 3) * 16];
#pragma unroll
        for (int i = 0; i < 8; ++i) rsv[i] = rsqrtf(rsv[i] * (1.f / (float)DM) + EPS);
        if (pn < 24) {
            const int which = pn >> 2; const bool rot = (which < 2) && (wc == 0); const float qs = (which == 0 || which == 3) ? QSCALE : 1.f;
            bf16_t* base = qkv + (size_t)which * ((size_t)T * 1024);
            f32x4 cs0 = {1.f, 0.f, 1.f, 0.f}, cs1 = {1.f, 0.f, 1.f, 0.f}, ns0 = cs0, ns1 = cs1;
            if (rot) { const int s0 = row0 & (SEQ - 1); cs0 = *(const f32x4*)(rope + ((size_t)s0 * 16 + 4 * fq) * 2); cs1 = *(const f32x4*)(rope + ((size_t)s0 * 16 + 4 * fq) * 2 + 4); }
#pragma unroll
            for (int i = 0; i < 8; ++i) { const int ai = i >> 2, m = i & 3; const int r = row0 + ai * HALF + m * 16; const float rs = rsv[i] * qs; const int b = r >> 13, sp = r & (SEQ - 1);
                if (rot && i < 7) { const int sn = (row0 + ((i + 1) >> 2) * HALF + ((i + 1) & 3) * 16) & (SEQ - 1);
                    ns0 = *(const f32x4*)(rope + ((size_t)sn * 16 + 4 * fq) * 2); ns1 = *(const f32x4*)(rope + ((size_t)sn * 16 + 4 * fq) * 2 + 4); }
                asm volatile("" ::: "memory");
#pragma unroll
                for (int bj = 0; bj < 2; ++bj) { const int head = 2 * (pn & 3) + bj;
                    f32x4 v0 = acc[ai][bj][m][0] * rs, v1 = acc[ai][bj][m][1] * rs;
                    if (rot) { f32x4 t0, t1;
                        t0[0] = v0[0] * cs0[0] - v0[1] * cs0[1]; t0[1] = v0[1] * cs0[0] + v0[0] * cs0[1]; t0[2] = v0[2] * cs0[2] - v0[3] * cs0[3]; t0[3] = v0[3] * cs0[2] + v0[2] * cs0[3];
                        t1[0] = v1[0] * cs1[0] - v1[1] * cs1[1]; t1[1] = v1[1] * cs1[0] + v1[0] * cs1[1]; t1[2] = v1[2] * cs1[2] - v1[3] * cs1[3]; t1[3] = v1[3] * cs1[2] + v1[2] * cs1[3];
                        v0 = t0; v1 = t1; }
                    u32x4 w; w.x = cvt_pk_bf16(v0[0], v0[1]); w.y = cvt_pk_bf16(v0[2], v0[3]); w.z = cvt_pk_bf16(v1[0], v1[1]); w.w = cvt_pk_bf16(v1[2], v1[3]);
                    *(u32x4*)(base + ((size_t)(b * NH + head) * SEQ + sp) * HD + wc * 32 + 8 * fq) = w; }
                cs0 = ns0; cs1 = ns1; }
        } else {
            const int gi = (pn - 24) >> 3, ct = (pn - 24) & 7; const float* bias = gi ? b_gf : b_gd; bf16_t* gb = gates + (size_t)gi * ((size_t)T * DM);
            const int col0 = ct * BM + wc * 32 + 8 * fq;
            f32x4 bv[2][2];
#pragma unroll
            for (int bj = 0; bj < 2; ++bj) { bv[bj][0] = *(const f32x4*)(bias + col0 + bj * HALF); bv[bj][1] = *(const f32x4*)(bias + col0 + bj * HALF + 4); }
#pragma unroll
            for (int ai = 0; ai < 2; ++ai)
#pragma unroll
                for (int m = 0; m < 4; ++m) { const int r = row0 + ai * HALF + m * 16; const float rs = rsv[ai * 4 + m];
#pragma unroll
                    for (int bj = 0; bj < 2; ++bj) { const f32x4 v0 = acc[ai][bj][m][0] * rs + bv[bj][0], v1 = acc[ai][bj][m][1] * rs + bv[bj][1];
                        u32x4 w; w.x = cvt_pk_bf16(sigmoidf_(v0[0]), sigmoidf_(v0[1])); w.y = cvt_pk_bf16(sigmoidf_(v0[2]), sigmoidf_(v0[3]));
                        w.z = cvt_pk_bf16(sigmoidf_(v1[0]), sigmoidf_(v1[1])); w.w = cvt_pk_bf16(sigmoidf_(v1[2]), sigmoidf_(v1[3]));
                        *(u32x4*)(gb + (size_t)r * DM + col0 + bj * HALF) = w; } }
        }
    }
};
struct EpiProj {
    static constexpr int STORES = 16;
    const bf16_t* gates; bf16_t* merged;
    __device__ __forceinline__ void operator()(AccRef acc, const Unit& u, int wr, int wc, int fr, int fq) const {
        const int row0 = u.pm * BM + wr * 64 + fr, col0 = u.pn * BM + wc * 32 + 8 * fq;
        const bf16_t* gb = gates + (size_t)u.half * ((size_t)T * DM);
        const u32x4 zz = {0u, 0u, 0u, 0u};
        u32x4 cg[2], cp[2] = {zz, zz}, ng[2], np[2] = {zz, zz};
        { const size_t off = (size_t)row0 * DM + col0; cg[0] = *(const u32x4*)(gb + off); cg[1] = *(const u32x4*)(gb + off + HALF);
          if (u.half) { cp[0] = *(const u32x4*)(merged + off); cp[1] = *(const u32x4*)(merged + off + HALF); } }
#pragma unroll
        for (int i = 0; i < 8; ++i) { const int ai = i >> 2, m = i & 3; const int r = row0 + ai * HALF + m * 16;
            if (i < 7) { const int rn = row0 + ((i + 1) >> 2) * HALF + ((i + 1) & 3) * 16; const size_t off = (size_t)rn * DM + col0;
                ng[0] = *(const u32x4*)(gb + off); ng[1] = *(const u32x4*)(gb + off + HALF);
                if (u.half) { np[0] = *(const u32x4*)(merged + off); np[1] = *(const u32x4*)(merged + off + HALF); } }
            asm volatile("" ::: "memory");
#pragma unroll
            for (int bj = 0; bj < 2; ++bj) { const size_t off = (size_t)r * DM + col0 + bj * HALF;
                const u32x4 gv = cg[bj], pv = cp[bj];
                f32x4 v0 = acc[ai][bj][m][0], v1 = acc[ai][bj][m][1];
                v0[0] *= bf_lo(gv.x); v0[1] *= bf_hi(gv.x); v0[2] *= bf_lo(gv.y); v0[3] *= bf_hi(gv.y);
                v1[0] *= bf_lo(gv.z); v1[1] *= bf_hi(gv.z); v1[2] *= bf_lo(gv.w); v1[3] *= bf_hi(gv.w);
                if (u.half) {
                    v0[0] += bf_lo(pv.x); v0[1] += bf_hi(pv.x); v0[2] += bf_lo(pv.y); v0[3] += bf_hi(pv.y);
                    v1[0] += bf_lo(pv.z); v1[1] += bf_hi(pv.z); v1[2] += bf_lo(pv.w); v1[3] += bf_hi(pv.w); }
                u32x4 w; w.x = cvt_pk_bf16(v0[0], v0[1]); w.y = cvt_pk_bf16(v0[2], v0[3]); w.z = cvt_pk_bf16(v1[0], v1[1]); w.w = cvt_pk_bf16(v1[2], v1[3]);
                *(u32x4*)(merged + off) = w; }
            cg[0] = ng[0]; cg[1] = ng[1]; cp[0] = np[0]; cp[1] = np[1]; }
    }
};
}

namespace att {
using bf16 = __hip_bfloat16;
constexpr int D = 128, NW = 8, QBLK = 32, KVBLK = 64, QB = NW * QBLK, LDO = 2048;
constexpr int SHM_V = KVBLK * D * 2, SHM_K = KVBLK * D * 2;
constexpr int LDS_WSF = 2 * SHM_V + 2 * SHM_K;
constexpr int LDS_CB = LDS_WSF + 2048;
constexpr int LDS_DT = LDS_CB + 32768;
constexpr int DT_N = 2624, DT_OFF = 320;
constexpr int LDS_SCAN = LDS_DT + DT_N * 4;
constexpr int LDS_END = LDS_SCAN + 64;
constexpr float THR2 = 11.5f;

#define KSWZ(row, colB) ((row) * 256 + ((colB) ^ (((row) & 7) << 4)))
#define SBAR() __builtin_amdgcn_sched_barrier(0)
__device__ __forceinline__ int v_st(int k, int c) { const int kk = (k & ~0xC) | ((k & 4) << 1) | ((k & 8) >> 1); return ((kk >> 3) * 4 + (c >> 5)) * 512 + ((kk & 7) * 32 + (c & 31)) * 2; }
__device__ __forceinline__ int v_rd_base(int lane) { return ((lane & 3) << 3) | (((lane >> 2) & 3) << 6) | (((lane >> 4) & 1) << 5) | (((lane >> 5) & 1) << 8); }
constexpr int v_rd_off(int d0, int ks, int half) { return d0 * 512 + ks * 4096 + half * 2048; }
__device__ __forceinline__ int crow(int r, int hi) { return (r & 3) + 8 * (r >> 2) + 4 * hi; }
__device__ __forceinline__ unsigned cvtpk(float lo, float hi) { unsigned r; asm volatile("v_cvt_pk_bf16_f32 %0, %1, %2" : "=v"(r) : "v"(lo), "v"(hi)); return r; }
__device__ __forceinline__ bf16x8 load8(const bf16* p) { return *reinterpret_cast<const bf16x8*>(p); }
__device__ __forceinline__ void mask_tile(f32x16& p0, f32x16& p1, int dq, unsigned W) {
    const float NEG = -__builtin_inff();
#pragma unroll
    for (int r = 0; r < 16; ++r) { const int c = (r & 3) + 8 * (r >> 2);
        if ((unsigned)(dq - c) >= W) p0[r] = NEG;
        if ((unsigned)(dq - c - 32) >= W) p1[r] = NEG; }
}
__device__ __forceinline__ void partialSM(f32x16& p0, f32x16& p1, float& m_reg, float& mn, float& alpha) {
    float pmax = p0[0];
#pragma unroll
    for (int r = 1; r < 16; ++r) pmax = fmaxf(pmax, p0[r]);
#pragma unroll
    for (int r = 0; r < 16; ++r) pmax = fmaxf(pmax, p1[r]);
    { auto rr = __builtin_amdgcn_permlane32_swap(__float_as_uint(pmax), __float_as_uint(pmax), false, false);
      pmax = fmaxf(__uint_as_float(rr[0]), __uint_as_float(rr[1])); }
    if (__builtin_expect(__all((pmax - m_reg) <= THR2), 1)) { mn = m_reg; alpha = 1.f; }
    else { mn = fmaxf(m_reg, pmax); alpha = __builtin_amdgcn_exp2f(m_reg - mn); m_reg = mn; }
#pragma unroll
    for (int r = 0; r < 16; ++r) p0[r] = p0[r] - mn;
#pragma unroll
    for (int r = 0; r < 16; ++r) p1[r] = p1[r] - mn;
#pragma unroll
    for (int r = 0; r < 16; ++r) p0[r] = __builtin_amdgcn_exp2f(p0[r]);
}
__device__ __forceinline__ void finishSM(f32x16& p0, f32x16& p1, float alpha, float& l_reg, bf16x8& pa0, bf16x8& pa1, bf16x8& pa2, bf16x8& pa3) {
#pragma unroll
    for (int r = 0; r < 16; ++r) p1[r] = __builtin_amdgcn_exp2f(p1[r]);
    float ps = 0;
#pragma unroll
    for (int r = 0; r < 16; ++r) ps += p0[r];
#pragma unroll
    for (int r = 0; r < 16; ++r) ps += p1[r];
    { auto rr = __builtin_amdgcn_permlane32_swap(__float_as_uint(ps), __float_as_uint(ps), false, false);
      ps = __uint_as_float(rr[0]) + __uint_as_float(rr[1]); }
    l_reg = l_reg * alpha + ps;
#define PK4(P, B_, OUT) do { unsigned a0 = cvtpk(P[B_+0], P[B_+1]), a1 = cvtpk(P[B_+2], P[B_+3]);                          \
        unsigned b0 = cvtpk(P[B_+4], P[B_+5]), b1 = cvtpk(P[B_+6], P[B_+7]);                                             \
        auto r0 = __builtin_amdgcn_permlane32_swap(a0, b0, false, false); auto r1 = __builtin_amdgcn_permlane32_swap(a1, b1, false, false); \
        u32x4 w = {r0[0], r1[0], r0[1], r1[1]}; OUT = *reinterpret_cast<bf16x8*>(&w); } while (0)
    PK4(p0, 0, pa0); PK4(p0, 8, pa1); PK4(p1, 0, pa2); PK4(p1, 8, pa3);
#undef PK4
}
template <int KB, int MODE>
__device__ __forceinline__ void qkt(f32x16& p0, f32x16& p1, const char* K_lds, int r32, int hi, const bf16x8* qr, const LAS float* cbt, const LAS float* dtab, int kb_, int qm) {
    if (MODE == 0) { const LAS float* cb_ = cbt + (kb_ + 4 * hi);
#pragma unroll
        for (int j_ = 0; j_ < 4; ++j_) { const f32x4 a_ = *(const LAS f32x4*)(cb_ + 8 * j_), b_ = *(const LAS f32x4*)(cb_ + 32 + 8 * j_);
            p0[4 * j_ + 0] = a_[0]; p0[4 * j_ + 1] = a_[1]; p0[4 * j_ + 2] = a_[2]; p0[4 * j_ + 3] = a_[3]; p1[4 * j_ + 0] = b_[0]; p1[4 * j_ + 1] = b_[1]; p1[4 * j_ + 2] = b_[2]; p1[4 * j_ + 3] = b_[3]; } }
    else { const LAS float* tb_ = dtab + (qm - kb_ + (DT_OFF - 59));
#pragma unroll
        for (int r_ = 0; r_ < 16; ++r_) { const int c_ = (r_ & 3) + 8 * (r_ >> 2); p0[r_] = tb_[59 - c_]; p1[r_] = tb_[27 - c_]; } }
    const char* kb[4];
#pragma unroll
    for (int dd = 0; dd < 4; ++dd) kb[dd] = K_lds + KB * SHM_K + KSWZ(r32, (dd * 16 + hi * 8) * 2);
#pragma unroll
    for (int d0 = 0; d0 < 8; ++d0) { const char* a = kb[d0 & 3] + (d0 >> 2) * 128;
        bf16x8 b0 = *reinterpret_cast<const bf16x8*>(a);
        bf16x8 b1 = *reinterpret_cast<const bf16x8*>(a + 32 * 256);
        p0 = __builtin_amdgcn_mfma_f32_32x32x16_bf16(b0, qr[d0], p0, 0, 0, 0);
        p1 = __builtin_amdgcn_mfma_f32_32x32x16_bf16(b1, qr[d0], p1, 0, 0, 0); }
}
template <int VB>
__device__ __forceinline__ void pv_tile(f32x16* o, int vb0, bf16x8 pa0, bf16x8 pa1, bf16x8 pa2, bf16x8 pa3) {
#define TRRD(dst, off) asm volatile("ds_read_b64_tr_b16 %0, %1 offset:%2" : "=&v"(dst) : "v"(vb0), "i"(off) : "memory")
#define PV_D0(d0) do { s16x4 l0, l1, l2, l3, h0, h1, h2, h3; constexpr int b_ = VB * SHM_V + v_rd_off(d0, 0, 0); \
        TRRD(l0, b_); TRRD(h0, b_ + 2048); TRRD(l1, b_ + 4096); TRRD(h1, b_ + 6144); TRRD(l2, b_ + 8192); TRRD(h2, b_ + 10240); TRRD(l3, b_ + 12288); TRRD(h3, b_ + 14336); \
        asm volatile("s_waitcnt lgkmcnt(0)" ::: "memory"); SBAR();   \
        o[d0] = __builtin_amdgcn_mfma_f32_32x32x16_bf16(pa0, (bf16x8){l0[0], l0[1], l0[2], l0[3], h0[0], h0[1], h0[2], h0[3]}, o[d0], 0, 0, 0);   \
        o[d0] = __builtin_amdgcn_mfma_f32_32x32x16_bf16(pa1, (bf16x8){l1[0], l1[1], l1[2], l1[3], h1[0], h1[1], h1[2], h1[3]}, o[d0], 0, 0, 0);   \
        o[d0] = __builtin_amdgcn_mfma_f32_32x32x16_bf16(pa2, (bf16x8){l2[0], l2[1], l2[2], l2[3], h2[0], h2[1], h2[2], h2[3]}, o[d0], 0, 0, 0);   \
        o[d0] = __builtin_amdgcn_mfma_f32_32x32x16_bf16(pa3, (bf16x8){l3[0], l3[1], l3[2], l3[3], h3[0], h3[1], h3[2], h3[3]}, o[d0], 0, 0, 0); } while (0)
    PV_D0(0); PV_D0(1); PV_D0(2); PV_D0(3);
#undef PV_D0
#undef TRRD
}

struct BlockRef { const bf16* Q; const bf16* K; const bf16* V; bf16* O; int P0; int W; };
struct Seam { bf16x8 qr[8]; bf16x8 st_v0, st_v1, st_k0, st_k1; };
__device__ __forceinline__ int swa_jlo(int P0, int W) { const int lowk = P0 - W + 1; return lowk > 0 ? lowk / KVBLK : 0; }
#define ROW(p, k0, rr) ((p) + (size_t)((k0) + (rr)) * D + sc)
#define VMW() asm volatile("s_waitcnt vmcnt(0)" ::: "memory")
#define VMWN(n) asm volatile("s_waitcnt vmcnt(%0)" :: "i"(n) : "memory")
#define SLOAD_H(Kp, Vp, k0) do { S.st_v0 = load8(ROW(Vp, k0, sr)); S.st_v1 = load8(ROW(Vp, k0, 32 + sr));              \
                         S.st_k0 = load8(ROW(Kp, k0, sr)); S.st_k1 = load8(ROW(Kp, k0, 32 + sr)); } while (0)
#define SWRITE_HK(bf) do { *(bf16x8*)(K_lds + (bf) * SHM_K + kws) = S.st_k0; *(bf16x8*)(K_lds + (bf) * SHM_K + kws + 32 * 256) = S.st_k1; } while (0)
#define SWRITE_HV(bf) do { *(bf16x8*)(V_lds + (bf) * SHM_V + vst0) = S.st_v0; *(bf16x8*)(V_lds + (bf) * SHM_V + vst1) = S.st_v1; } while (0)
#define SWRITE_H(bf) do { SWRITE_HV(bf); SWRITE_HK(bf); } while (0)
template <int MODE>
__device__ __forceinline__ void attn_prime(const BlockRef& cur, char* lds, Seam& S) {
    int tid_ = threadIdx.x; asm volatile("" : "+v"(tid_));
    const int tid = tid_, wid = __builtin_amdgcn_readfirstlane(tid >> 6), lane = tid & 63, r32 = lane & 31, hi = lane >> 5;
    const int sr = tid >> 4, sc = (tid & 15) * 8, kws = KSWZ(sr, sc * 2); char* K_lds = lds + 2 * SHM_V;
    const int kb0 = MODE == 0 ? cur.P0 + QB - KVBLK : swa_jlo(cur.P0, cur.W) * KVBLK;
#pragma unroll
    for (int d0 = 0; d0 < 8; ++d0) S.qr[d0] = load8(cur.Q + (size_t)(wid * QBLK + r32) * D + d0 * 16 + hi * 8);
    SLOAD_H(cur.K, cur.V, kb0); VMW(); SWRITE_HK(0);
    __syncthreads();
}
template <int MODE>
__device__ __forceinline__ void attn_block(const BlockRef& cur, const BlockRef& nxt, char* lds, const LAS float* cbt, const LAS float* dtab, Seam& S) {
    int tid_ = threadIdx.x; asm volatile("" : "+v"(tid_));
    const int tid = tid_, wid = __builtin_amdgcn_readfirstlane(tid >> 6), lane = tid & 63, r32 = lane & 31, hi = lane >> 5;
    const int W = cur.W;
    const int j_lo = swa_jlo(cur.P0, W);
    const int j_hi = (cur.P0 + QB - 1) / KVBLK + 1;
    const int NT = j_hi - j_lo;
    const int kbn = MODE == 0 ? nxt.P0 + QB - KVBLK : swa_jlo(nxt.P0, nxt.W) * KVBLK;
    const int qlo = cur.P0 + wid * QBLK, qm = qlo + r32 - 4 * hi;
    char* V_lds = lds; char* K_lds = lds + 2 * SHM_V;
    float* ws = (float*)(lds + LDS_WSF) + wid * 64; float* li_l = ws, * al_l = ws + 32;
    float m_reg = -1e30f, l_reg = 0; f32x16 o[4] = {};
    const int sr = tid >> 4, sc = (tid & 15) * 8, vst0 = v_st(sr, sc), vst1 = v_st(32 + sr, sc), kws = KSWZ(sr, sc * 2);
    const int vb0 = (int)(uintptr_t)V_lds + v_rd_base(lane);
    const bf16* Kh = cur.K; const bf16* Vh = cur.V;
#define RESC(a) do { if (__any((a) < 1.f)) { if (hi == 0) al_l[r32] = (a); asm volatile("s_waitcnt lgkmcnt(0)" ::: "memory");              \
                     for (int d_ = 0; d_ < 4; ++d_) for (int r = 0; r < 16; ++r) o[d_][r] *= al_l[crow(r, hi)]; } } while (0)
#define KBASE(t) ((MODE == 0 ? (j_hi - 1 - (t)) : (j_lo + (t))) * KVBLK)
#define MASKT(P0_, P1_, t) do { if (MODE == 0) { const int kb_ = KBASE(t); if (kb_ + KVBLK - 1 > qlo) mask_tile(P0_, P1_, qm - kb_, (unsigned)W); } } while (0)
    constexpr int NQL = 8;
#define SEAM_K0() do { VMWN(NQL); SWRITE_HK(0); SBAR(); } while (0)
    f32x16 pA0, pA1, pB0, pB1; float mnA, mnB, alA, alB; bf16x8 pa0, pa1, pa2, pa3;
    SWRITE_HV(0); SBAR();
    if (NT > 1) { SLOAD_H(Kh, Vh, KBASE(1)); }
    SBAR(); qkt<0, MODE>(pA0, pA1, K_lds, r32, hi, S.qr, cbt, dtab, KBASE(0), qm);
    MASKT(pA0, pA1, 0); partialSM(pA0, pA1, m_reg, mnA, alA);
    if (NT > 1) { VMW(); SWRITE_H(1); }
    __syncthreads();
#define HALF_STEP(PX0, PX1, mnX, alX, PY0, PY1, alY, t, KB, VB, SB) do {                                                      \
        SBAR(); qkt<KB, MODE>(PX0, PX1, K_lds, r32, hi, S.qr, cbt, dtab, KBASE(t), qm);                                             \
        finishSM(PY0, PY1, alY, l_reg, pa0, pa1, pa2, pa3); SBAR();                                                           \
        if ((t) + 1 < NT) { SLOAD_H(Kh, Vh, KBASE((t) + 1)); SBAR(); }                                               \
        pv_tile<VB>(o, vb0, pa0, pa1, pa2, pa3); MASKT(PX0, PX1, (t)); partialSM(PX0, PX1, m_reg, mnX, alX);                                        \
        __syncthreads();                                                                                                      \
        if ((t) + 1 < NT) { VMW(); SWRITE_H(SB); }                                                                          \
        RESC(alX); __syncthreads(); } while (0)
    for (int t = 1; t + 1 < NT; t += 2) {
        HALF_STEP(pB0, pB1, mnB, alB, pA0, pA1, alA, t, 1, 0, 0);
        HALF_STEP(pA0, pA1, mnA, alA, pB0, pB1, alB, t + 1, 0, 1, 1);
    }
    const bool even = (NT & 1) == 0;
    if (even) { SBAR(); qkt<1, MODE>(pB0, pB1, K_lds, r32, hi, S.qr, cbt, dtab, KBASE(NT - 1), qm); SBAR(); }
    SLOAD_H(nxt.K, nxt.V, kbn); SBAR();
#pragma unroll
    for (int d0 = 0; d0 < 8; ++d0) S.qr[d0] = load8(nxt.Q + (size_t)(wid * QBLK + r32) * D + d0 * 16 + hi * 8);
    SBAR();
    finishSM(pA0, pA1, alA, l_reg, pa0, pa1, pa2, pa3); SBAR();
    pv_tile<0>(o, vb0, pa0, pa1, pa2, pa3);
    if (even) { MASKT(pB0, pB1, NT - 1); partialSM(pB0, pB1, m_reg, mnB, alB); __syncthreads(); RESC(alB);
        finishSM(pB0, pB1, alB, l_reg, pa0, pa1, pa2, pa3); SBAR(); pv_tile<1>(o, vb0, pa0, pa1, pa2, pa3); }
    SBAR(); SEAM_K0();
    if (hi == 0) li_l[r32] = l_reg; asm volatile("s_waitcnt lgkmcnt(0)" ::: "memory");
    float rli[16];
#pragma unroll
    for (int r = 0; r < 16; ++r) rli[r] = __builtin_amdgcn_rcpf(li_l[crow(r, hi)]);
    int lo_ = 4 * hi * LDO + r32; asm volatile("" : "+v"(lo_));
#pragma unroll
    for (int r = 0; r < 16; ++r) { bf16* rowp = cur.O + (size_t)(wid * QBLK + (r & 3) + 8 * (r >> 2)) * LDO;
#pragma unroll
        for (int d0 = 0; d0 < 4; ++d0) { const float v = o[d0][r] * rli[r];
            const float vn = __shfl_xor(v, 1);
            if ((r32 & 1) == 0) *(unsigned*)(rowp + lo_ + d0 * 32) = cvtpk(v, vn); } }
    __syncthreads();
#undef RESC
#undef KBASE
#undef MASKT
#undef SEAM_K0
#undef HALF_STEP
}
#undef ROW
#undef VMW
#undef VMWN
#undef SLOAD_H
#undef SWRITE_HK
#undef SWRITE_HV
#undef SWRITE_H

__device__ __forceinline__ void build_cb(const float* lf, int n, LAS float* cbt, LAS float* scan, int tid_in) {
    int tid = tid_in; asm volatile("" : "+v"(tid));
    const int lane = tid & 63, wid = tid >> 6, i0 = tid * 16;
    f32x4 v[4]; float tot = 0.f;
    if (i0 < n) {
#pragma unroll
        for (int j = 0; j < 4; ++j) v[j] = *(const f32x4*)(lf + i0 + 4 * j);
    } else {
#pragma unroll
        for (int j = 0; j < 4; ++j) v[j] = (f32x4){0.f, 0.f, 0.f, 0.f};
    }
#pragma unroll
    for (int j = 0; j < 4; ++j) { v[j][0] += tot; v[j][1] += v[j][0]; v[j][2] += v[j][1]; v[j][3] += v[j][2]; tot = v[j][3]; }
    float inc = tot;
#pragma unroll
    for (int o = 1; o < 64; o <<= 1) { const float t = __shfl_up(inc, o); if (lane >= o) inc += t; }
    if (lane == 63) scan[wid] = inc;
    __syncthreads();
    float base = inc - tot;
    for (int w = 0; w < wid; ++w) base += scan[w];
    if (i0 < n) {
#pragma unroll
        for (int j = 0; j < 4; ++j) { f32x4 o4; o4[0] = -(v[j][0] + base) * LOG2E; o4[1] = -(v[j][1] + base) * LOG2E; o4[2] = -(v[j][2] + base) * LOG2E; o4[3] = -(v[j][3] + base) * LOG2E;
            *(LAS f32x4*)(cbt + i0 + 4 * j) = o4; }
    }
    __syncthreads();
}
#undef SBAR
}

#define XB_TMO      128
#define XB_XCNT(j)  (256  + 64 * (j))
#define XB_XSUB(j)  (1280 + 64 * (j))
#define XB_XGEN(j)  (2304 + 64 * (j))
#define XB_TOP      3328
#define XB_TOPGEN   3392
#define XCD_BAR_WORDS 3456
#define XB_SPIN_CAP (1u << 18)

__device__ __forceinline__ unsigned xb_ld(unsigned* p)              { return __hip_atomic_load(p, __ATOMIC_RELAXED, __HIP_MEMORY_SCOPE_AGENT); }
__device__ __forceinline__ unsigned xb_add(unsigned* p, unsigned v) { return __hip_atomic_fetch_add(p, v, __ATOMIC_RELAXED, __HIP_MEMORY_SCOPE_AGENT); }
__device__ __forceinline__ unsigned xb_xcc_id() { return (unsigned)__builtin_amdgcn_s_getreg((3 << 11) | 20) & 0xFu; }
#define XB_SPIN(cond, bar) do { unsigned _sp = 0; while (cond) { __builtin_amdgcn_s_sleep(1); \
    if ((++_sp & 255u) == 0u) { if (xb_ld(&(bar)[XB_TMO])) break; if (_sp > XB_SPIN_CAP) { atomicAdd(&(bar)[XB_TMO], 1u); break; } } } } while (0)

struct XcdBarrier {
    unsigned* bar; unsigned x;
    volatile LAS unsigned* st;
};

__device__ __forceinline__ XcdBarrier xcd_barrier_post(unsigned* bar, volatile LAS unsigned* st) {
    XcdBarrier b; b.bar = bar; b.x = xb_xcc_id(); b.st = st;
    if (threadIdx.x == 0) (void)xb_add(&bar[XB_XCNT(b.x)], 1u);
    return b;
}
__device__ __forceinline__ void xcd_barrier_complete(unsigned* bar, unsigned x, unsigned& nloc, unsigned& nx) {
    const unsigned G = gridDim.x * gridDim.y * gridDim.z;
    unsigned sum, cnt, mine, sp = 0u;
    for (;;) {
        sum = 0u; cnt = 0u; mine = 0u;
#pragma unroll
        for (unsigned j = 0; j < 16; ++j) { const unsigned c = xb_ld(&bar[XB_XCNT(j)]); sum += c; cnt += (c > 0u) ? 1u : 0u; mine = (j == x) ? c : mine; }
        if (sum == G) break;
        __builtin_amdgcn_s_sleep(1);
        if ((++sp & 255u) == 0u) { if (xb_ld(&bar[XB_TMO])) break; if (sp > XB_SPIN_CAP) { atomicAdd(&bar[XB_TMO], 1u); break; } }
    }
    nloc = mine > 0u ? mine : 1u; nx = cnt > 0u ? cnt : 1u;
}

__device__ __forceinline__ void xcd_barrier(const XcdBarrier& b) {
    asm volatile("s_waitcnt vmcnt(0)" ::: "memory");
    __syncthreads();
    if (threadIdx.x == 0) {
        unsigned* bar = b.bar;
        __builtin_amdgcn_s_waitcnt(0);
        unsigned nloc = b.st[0], nx = b.st[1];
        if (nloc == 0u) { xcd_barrier_complete(bar, b.x, nloc, nx); b.st[0] = nloc; b.st[1] = nx; }
        const unsigned old = xb_add(&bar[XB_XSUB(b.x)], 1u);
        const unsigned gen = old / nloc;
        if (old + 1u == (gen + 1u) * nloc) {
            __builtin_amdgcn_fence(__ATOMIC_RELEASE, "agent");
            asm volatile("s_waitcnt vmcnt(0)" ::: "memory");
            const unsigned og = xb_add(&bar[XB_TOP], 1u);
            const unsigned tg = og / nx;
            if (og + 1u == (tg + 1u) * nx) xb_add(&bar[XB_TOPGEN], 1u);
            else XB_SPIN(xb_ld(&bar[XB_TOPGEN]) == tg, bar);
            __builtin_amdgcn_fence(__ATOMIC_ACQUIRE, "agent");
            xb_add(&bar[XB_XGEN(b.x)], 1u);
            asm volatile("s_waitcnt vmcnt(0)" ::: "memory");
        } else {
            XB_SPIN(xb_ld(&bar[XB_XGEN(b.x)]) == gen, bar);
            __builtin_amdgcn_fence(__ATOMIC_ACQUIRE, "agent");
            asm volatile("s_waitcnt vmcnt(0)" ::: "memory");
        }
    }
    __syncthreads();
}

struct Args { const float* in[18]; float* out; unsigned char* ws; int ph_lo, ph_hi; };

__constant__ float c_invfreq[16] = {1.000000000e+00f, 4.403665960e-01f, 1.939227432e-01f, 8.539710194e-02f, 3.760603070e-02f, 1.656043902e-02f, 7.292664610e-03f, 3.211445874e-03f,
                                    1.414213562e-03f, 6.227723788e-04f, 2.742481884e-04f, 1.207697351e-04f, 5.318296098e-05f, 2.341999971e-05f, 1.031338616e-05f, 4.541670478e-06f};

__device__ __forceinline__ int rowmap(int mode, int n, int row_off) {
    if (mode == 0) return n + row_off;
    if (mode == 1) return (n >> 7) * 256 + (n & 127);
    if (mode == 2) return (n >> 7) * 256 + 128 + (n & 127);
    if (n < 6144) { const int seg = n >> 10, d = n & 127; if (seg < 2 && d < 32) { const int dn = d < 16 ? 2 * d : 2 * (d - 16) + 1; return n - d + dn; } return n; }
    if (n < 6152) return 10240 + (n - 6144);
    if (n < 8200) return 6144 + (n - 6152);
    return 8192 + (n - 8200);
}
struct CvtDesc { const float* W; int K, N; bf16_t* WT; int ldk, kofs, mode; const float* gain; int item; };
__device__ __forceinline__ void cvt_load(const CvtDesc& d, f32x4 (&v)[8], int lane) {
    const int nblk = (d.N + 31) / 32, kb = d.item / nblk, nb = d.item - kb * nblk, k0 = 64 * kb, n0 = 32 * nb;
    const int nn = n0 + 4 * (lane & 7); const bool ok = nn < d.N;
    const float* p = d.W + (size_t)(k0 + (lane >> 3)) * d.N + nn;
#pragma unroll
    for (int i = 0; i < 8; ++i) v[i] = ok ? *(const f32x4*)(p + (size_t)(8 * i) * d.N) : (f32x4){0.f, 0.f, 0.f, 0.f};
}
__device__ __forceinline__ void cvt_store(const CvtDesc& d, const f32x4 (&v)[8], LAS float* scr, int lane) {
    const int nblk = (d.N + 31) / 32, kb = d.item / nblk, nb = d.item - kb * nblk, k0 = 64 * kb, n0 = 32 * nb;
#pragma unroll
    for (int i = 0; i < 8; ++i) { LAS float* q = scr + (8 * i + (lane >> 3)) * 33 + 4 * (lane & 7); q[0] = v[i][0]; q[1] = v[i][1]; q[2] = v[i][2]; q[3] = v[i][3]; }
    asm volatile("s_waitcnt lgkmcnt(0)" ::: "memory");
    const int c = lane & 7;
    f32x4 g0 = {1.f, 1.f, 1.f, 1.f}, g1 = {1.f, 1.f, 1.f, 1.f};
    if (d.gain) { g0 = *(const f32x4*)(d.gain + k0 + 8 * c); g1 = *(const f32x4*)(d.gain + k0 + 8 * c + 4); }
#pragma unroll
    for (int j = 0; j < 4; ++j) { const int n = (lane >> 3) + 8 * j; const LAS float* s = scr + (8 * c) * 33 + n;
        u32x4 o; o.x = cvt_pk_bf16(s[0 * 33] * g0[0], s[1 * 33] * g0[1]); o.y = cvt_pk_bf16(s[2 * 33] * g0[2], s[3 * 33] * g0[3]);
        o.z = cvt_pk_bf16(s[4 * 33] * g1[0], s[5 * 33] * g1[1]); o.w = cvt_pk_bf16(s[6 * 33] * g1[2], s[7 * 33] * g1[3]);
        if (n0 + n < d.N) *(u32x4*)(d.WT + (size_t)rowmap(d.mode, n0 + n, 0) * d.ldk + d.kofs + k0 + 8 * c) = o; }
    asm volatile("s_waitcnt lgkmcnt(0)" ::: "memory");
}
struct CvtTab { const float* in[18]; bf16_t *Wgu, *Wd, *Win, *Wp, *Wout; };
constexpr int CI_G = (DM / 64) * (FF / 32), CI_D = (FF / 64) * (DM / 32), CI_IN = (DM / 64) * ((INC + 31) / 32), CI_P = (1024 / 64) * (DM / 32), CI_O = (DM / 64) * (DM / 32);
constexpr int CVT_N0 = 2 * CI_G + CI_D + CI_IN + 2 * CI_P + CI_O;
constexpr int CVT_N1 = 2 * CI_G + CI_D;
__device__ __forceinline__ CvtDesc cvt_decode(const CvtTab& t, int list, int it) {
    CvtDesc d; int r = it; const int fb = list == 0 ? 2 : 14; const float* gn = t.in[list == 0 ? 1 : 13];
    if (r < CI_G) { d = CvtDesc{t.in[fb], DM, FF, t.Wgu, DM, 0, 1, gn, r}; return d; } r -= CI_G;
    if (r < CI_G) { d = CvtDesc{t.in[fb + 1], DM, FF, t.Wgu, DM, 0, 2, gn, r}; return d; } r -= CI_G;
    if (r < CI_D) { d = CvtDesc{t.in[fb + 2], FF, DM, t.Wd, FF, 0, 0, nullptr, r}; return d; } r -= CI_D;
    if (r < CI_IN) { d = CvtDesc{t.in[6], DM, INC, t.Win, DM, 0, 3, t.in[5], r}; return d; } r -= CI_IN;
    if (r < CI_P) { d = CvtDesc{t.in[10], 1024, DM, t.Wp, DM, 0, 0, nullptr, r}; return d; } r -= CI_P;
    if (r < CI_P) { d = CvtDesc{t.in[11], 1024, DM, t.Wp, DM, 1024, 0, nullptr, r}; return d; } r -= CI_P;
    d = CvtDesc{t.in[12], DM, DM, t.Wout, DM, 0, 0, nullptr, r}; return d;
}
__device__ __forceinline__ void convert_list(const CvtTab& t, int list, int nitems, LAS float* scr, int gw, int NGW, int lane) {
    f32x4 va[8], vb[8], vc[8];
    CvtDesc da, db, dc;
    int ia = gw, ib = gw + NGW, ic = gw + 2 * NGW;
    if (ia < nitems) { da = cvt_decode(t, list, ia); cvt_load(da, va, lane); }
    if (ib < nitems) { db = cvt_decode(t, list, ib); cvt_load(db, vb, lane); }
    while (ia < nitems) {
        if (ic < nitems) { dc = cvt_decode(t, list, ic); cvt_load(dc, vc, lane); }
        cvt_store(da, va, scr, lane);
        ia = ic + NGW;
        if (ia < nitems) { da = cvt_decode(t, list, ia); cvt_load(da, va, lane); }
        if (ib < nitems) cvt_store(db, vb, scr, lane);
        ib = ia + NGW;
        if (ib < nitems) { db = cvt_decode(t, list, ib); cvt_load(db, vb, lane); }
        if (ic < nitems) cvt_store(dc, vc, scr, lane);
        ic = ib + NGW;
    }
}

#ifndef MK_LAUNCHES
#define MK_LAUNCHES 1
#endif
constexpr int LDS_BYTES = 147456;

__global__ void __launch_bounds__(512, 2) fwd_megakernel(Args a) {
    extern __shared__ __attribute__((aligned(16))) unsigned char lds_raw[];
#if MK_LAUNCHES == 1
    cg::grid_group grid = cg::this_grid();
#endif
    LAS unsigned char* lds = (LAS unsigned char*)lds_raw;

#if MK_LAUNCHES == 1
    { volatile LAS unsigned* st0 = (volatile LAS unsigned*)(lds + LDS_BYTES - 64); if (threadIdx.x < 16) st0[threadIdx.x] = 0u; }
    __syncthreads();
    const XcdBarrier xbar = xcd_barrier_post((unsigned*)(a.ws + WS_BAR), (volatile LAS unsigned*)(lds + LDS_BYTES - 64));
#define GSYNC() xcd_barrier(xbar)
#define IN(k) true
    grid.sync();
#else
#define GSYNC() do { } while (0)
#define IN(k) (a.ph_lo == (k))
#endif
#define PHASE_IDS int tid_ = threadIdx.x; asm volatile("" : "+v"(tid_)); const int tid = tid_, lane = tid & 63, wave = __builtin_amdgcn_readfirstlane(tid >> 6); \
    const int gw = vcu * 8 + wave, NGW = G * 8, gt = vcu * 512 + tid, NGT = G * 512; LAS float* scr = (LAS float*)(lds + wave * 16384); (void)gw; (void)NGW; (void)gt; (void)NGT; (void)scr; (void)lane;
    const int G = gridDim.x, bx = blockIdx.x;
    const int vcu = (G % 8 == 0) ? (bx % 8) * (G / 8) + bx / 8 : bx;
    unsigned char* ws = a.ws;
    float* ssq0 = (float*)(ws + WS_SSQ); float* ssq1 = ssq0 + T; float* ssq2 = ssq1 + T; float* ssq3 = ssq2 + T;
    float* rope = (float*)(ws + WS_ROPE); float* logf = (float*)(ws + WS_LOGF);
    bf16_t* Wgu = (bf16_t*)(ws + WS_WGU); bf16_t* Wd = (bf16_t*)(ws + WS_WD); bf16_t* Win = (bf16_t*)(ws + WS_WIN);
    bf16_t* Wp = (bf16_t*)(ws + WS_WP); bf16_t* Wout = (bf16_t*)(ws + WS_WOUT);
    bf16_t* xb = (bf16_t*)(ws + WS_XB); bf16_t* act = (bf16_t*)(ws + WS_BIG); bf16_t* qkv = (bf16_t*)(ws + WS_BIG); bf16_t* merged = (bf16_t*)(ws + WS_BIG);
    bf16_t* gates = (bf16_t*)(ws + WS_GATES);
    const float* x = a.in[0]; float* out = a.out;

    if (IN(0))
    {
        PHASE_IDS
#ifndef REP0
#define REP0 1
#endif
        for (int rep0 = 0; rep0 < REP0; ++rep0) {
        { CvtTab ct; for (int i = 0; i < 18; ++i) ct.in[i] = a.in[i]; ct.Wgu = Wgu; ct.Wd = Wd; ct.Win = Win; ct.Wp = Wp; ct.Wout = Wout;
          convert_list(ct, 0, CVT_N0, scr, gw, NGW, lane); }
#ifdef DIAG_POISON
        { const u32x4 pz = {0xAAAAAAAAu, 0xAAAAAAAAu, 0xAAAAAAAAu, 0xAAAAAAAAu};
          for (size_t i = gt; i < (WS_END - WS_BIG) / 16; i += NGT) *(u32x4*)(ws + WS_BIG + i * 16) = pz;
          for (size_t i = gt; i < (512 * 1024) / 16; i += NGT) *(u32x4*)(ws + WS_LOGF + i * 16) = pz;
          for (size_t i = gt; i < ((size_t)T * DM * 4) / 16; i += NGT) *(u32x4*)((unsigned char*)out + i * 16) = pz; }
#endif
        for (int i = gt; i < (NIN - INC) * DM / 8; i += NGT) *(u32x4*)(Win + (size_t)INC * DM + (size_t)i * 8) = (u32x4){0u, 0u, 0u, 0u};
        for (int i = gt; i < 3 * T; i += NGT) ssq1[i] = 0.f;
        for (int i = gt; i < SEQ * 16; i += NGT) { const int pos = i >> 4, f = i & 15; const float ang = (float)pos * c_invfreq[f];
            double rev = (double)ang * 0.15915494309189535; rev -= __builtin_rint(rev); const float fr = (float)rev;
            rope[2 * i] = __builtin_amdgcn_cosf(fr); rope[2 * i + 1] = __builtin_amdgcn_sinf(fr); }
        for (int m = gw; m < T; m += NGW) { const f32x4* xr = (const f32x4*)(x + (size_t)m * DM) + lane; float s = 0.f;
            u32x2* o8 = (u32x2*)(xb + (size_t)m * DM) + lane;
#pragma unroll
            for (int j = 0; j < 8; ++j) { const f32x4 v = xr[64 * j]; s += (v[0] * v[0] + v[1] * v[1]) + (v[2] * v[2] + v[3] * v[3]);
                u32x2 w; w.x = cvt_pk_bf16(v[0], v[1]); w.y = cvt_pk_bf16(v[2], v[3]); o8[64 * j] = w; }
            s = wave_sum(s); if (lane == 0) ssq0[m] = s; }
        asm volatile("" ::: "memory"); }
    }
    GSYNC();
    if (IN(1))
    { pg8::Gemm g{xb, Wgu, DM, DM, DM}; pg8::StaticOrder S; S.init(T, NGU, G, bx); pg8::EpiSwiGLU E{act, ssq0}; pg8::gemm_phase(lds, g, S, E); }
    GSYNC();
    if (IN(2))
    { pg8::Gemm g{act, Wd, FF, FF, FF}; pg8::StaticOrder S; S.init(T, DM, G, bx); pg8::EpiResid E{x, out, xb, ssq1, 0.5f}; pg8::gemm_phase(lds, g, S, E); }
    GSYNC();
    if (IN(3))
    { pg8::Gemm g{xb, Win, DM, DM, DM}; pg8::StaticOrder S; S.init(T, 10240, G, bx); pg8::EpiWin E{qkv, gates, logf, ssq1, rope, a.in[7], a.in[8], a.in[9]}; pg8::gemm_phase(lds, g, S, E); }
    if (IN(3))
    {
        PHASE_IDS
        const bf16_t* Wf = Win + (size_t)10240 * DM; const float* b_forget = a.in[7];
        for (int m = gw; m < T; m += NGW) {
            const u32x4* xr = (const u32x4*)(xb + (size_t)m * DM) + lane; u32x4 xv[4];
#pragma unroll
            for (int j = 0; j < 4; ++j) xv[j] = xr[64 * j];
            float accf[8];
#pragma unroll
            for (int h = 0; h < 8; ++h) { const u32x4* wr_ = (const u32x4*)(Wf + (size_t)h * DM) + lane; float sacc = 0.f;
#pragma unroll
                for (int j = 0; j < 4; ++j) { const u32x4 wv = wr_[64 * j];
                    sacc += bf_lo(xv[j].x) * bf_lo(wv.x) + bf_hi(xv[j].x) * bf_hi(wv.x) + bf_lo(xv[j].y) * bf_lo(wv.y) + bf_hi(xv[j].y) * bf_hi(wv.y)
                          + bf_lo(xv[j].z) * bf_lo(wv.z) + bf_hi(xv[j].z) * bf_hi(wv.z) + bf_lo(xv[j].w) * bf_lo(wv.w) + bf_hi(xv[j].w) * bf_hi(wv.w); }
                accf[h] = wave_sum(sacc); }
            if (lane < 8) { float v = accf[0];
#pragma unroll
                for (int h = 1; h < 8; ++h) v = (lane == h) ? accf[h] : v;
                const float z = v * pg8::rstd_of(ssq1, m) + b_forget[lane];
                const float ls = fminf(z, 0.f) - __logf(1.f + __expf(-fabsf(z)));
                logf[(size_t)((m >> 13) * NH + lane) * SEQ + (m & (SEQ - 1))] = ls; }
        }
    }
    GSYNC();
    if (IN(4))
    {
        using namespace att;
        PHASE_IDS
        char* al = (char*)lds_raw;
        LAS float* cbt = (LAS float*)(lds + LDS_CB); LAS float* dtab = (LAS float*)(lds + LDS_DT); LAS float* scan = (LAS float*)(lds + LDS_SCAN);
        for (int i = tid; i < DT_N; i += 512) { const int dl = i - DT_OFF; float v = -__builtin_inff();
            if (dl >= 0 && dl <= 2048) { const int mlt = (dl <= 128 ? 1 : 0) + (((dl & 3) == 0 && dl <= 512) ? 1 : 0) + (((dl & 15) == 0) ? 1 : 0);
                v = mlt == 0 ? -__builtin_inff() : (mlt == 1 ? 0.f : (mlt == 2 ? 1.f : 1.5849625007211562f)); }
            dtab[i] = v; }
        __syncthreads();
        constexpr int NFOX = 256, NDIL = 256, TOTAL = NFOX + NDIL;
        const bf16* qkvb = (const bf16*)qkv; bf16* ycat = (bf16*)xb;
        struct Item { int mode, bh, qb0, qb1; };
        auto decode = [&](int L) { Item it; const unsigned long long FA = 0x5432DB910AFEC876ull;
            if (L < NFOX) { it.mode = 0; it.bh = L >> 4; const int sl = L & 15; it.qb0 = (int)((FA >> (4 * sl)) & 15);
                const int sums = sl < 8 ? 37 - sl : (sl < 12 ? 29 : 28); it.qb1 = sums - it.qb0; }
            else { const int l2 = L - NFOX; it.mode = 1; it.bh = l2 >> 4; const int sl = l2 & 15; if (sl < 8) { it.qb0 = sl; it.qb1 = 8 + sl; } else { it.qb0 = 2 * sl; it.qb1 = 2 * sl + 1; } }
            return it; };
        auto mkref = [&](const Item& it, int pass) { const int qb = pass ? it.qb1 : it.qb0; BlockRef r; const size_t seg = (size_t)T * 1024; const int sb = it.mode == 0 ? 3 : 0;
            const size_t hb = (size_t)it.bh * SEQ * HD;
            r.Q = qkvb + (sb + 0) * seg + hb + (size_t)qb * QB * HD; r.K = qkvb + (sb + 1) * seg + hb; r.V = qkvb + (sb + 2) * seg + hb;
            r.O = ycat + ((size_t)(it.bh >> 3) * SEQ + (size_t)qb * QB) * LDO + (it.mode == 0 ? 1024 : 0) + (it.bh & 7) * HD; r.P0 = qb * QB; r.W = it.mode == 0 ? (1 << 30) : 2049;
            return r; };
#define ATT_STREAM(MODE_, LBEG, LEND) do { int L = (LBEG) + vcu; if (L < (LEND)) { \
            Item it = decode(L); int pass = 0; BlockRef cur = mkref(it, 0); Seam S; \
            attn_prime<MODE_>(cur, al, S); \
            for (;;) { \
                const bool more_pass = pass == 0 && it.qb1 != it.qb0, more_item = L + G < (LEND), last = !more_pass && !more_item; \
                Item itn = it; int passn = pass + 1, Ln = L; \
                if (!more_pass) { passn = 0; Ln = more_item ? L + G : L; itn = decode(Ln); } \
                const BlockRef nxt = last ? cur : mkref(itn, passn); \
                if (MODE_ == 0 && pass == 0) { const int mq = it.qb0 > it.qb1 ? it.qb0 : it.qb1; build_cb(logf + (size_t)it.bh * SEQ, (mq + 1) * QB, cbt, scan, tid); } \
                attn_block<MODE_>(cur, nxt, al, cbt, dtab, S); \
                if (last) break; \
                cur = nxt; it = itn; pass = passn; L = Ln; \
            } } } while (0)
#ifndef REP4
#define REP4 1
#endif
        for (int rep4 = 0; rep4 < REP4; ++rep4) {
        ATT_STREAM(0, 0, NFOX);
        __syncthreads();
        ATT_STREAM(1, NFOX, TOTAL);
        __syncthreads(); }
#undef ATT_STREAM
    }
    GSYNC();
    if (IN(5))
    {
        PHASE_IDS
        { CvtTab ct; for (int i = 0; i < 18; ++i) ct.in[i] = a.in[i]; ct.Wgu = Wgu; ct.Wd = Wd; ct.Win = Win; ct.Wp = Wp; ct.Wout = Wout;
          convert_list(ct, 1, CVT_N1, scr, gw, NGW, lane); }
        __syncthreads();
        pg8::Gemm g{xb, Wp, 1024, DM, DM}; pg8::StaticOrder S; S.init(T, DM, G, bx, 2); pg8::EpiProj E{gates, merged}; pg8::gemm_phase(lds, g, S, E);
    }
    GSYNC();
    if (IN(6))
    { pg8::Gemm g{merged, Wout, DM, DM, DM}; pg8::StaticOrder S; S.init(T, DM, G, bx); pg8::EpiResid E{out, out, xb, ssq2, 1.0f}; pg8::gemm_phase(lds, g, S, E); }
    GSYNC();
    if (IN(7))
    { pg8::Gemm g{xb, Wgu, DM, DM, DM}; pg8::StaticOrder S; S.init(T, NGU, G, bx); pg8::EpiSwiGLU E{act, ssq2}; pg8::gemm_phase(lds, g, S, E); }
    GSYNC();
    if (IN(8))
    { pg8::Gemm g{act, Wd, FF, FF, FF}; pg8::StaticOrder S; S.init(T, DM, G, bx); pg8::EpiResid E{out, out, nullptr, ssq3, 0.5f}; pg8::gemm_phase(lds, g, S, E); }
    GSYNC();
    if (IN(9))
    {
        PHASE_IDS
        const float* fn = a.in[17];
        for (int m = gw; m < T; m += NGW) { f32x4* xr = (f32x4*)(out + (size_t)m * DM) + lane; const float rs = rsqrtf(ssq3[m] * (1.f / (float)DM) + EPS);
#pragma unroll
            for (int j = 0; j < 8; ++j) { const f32x4 gg = *((const f32x4*)fn + lane + 64 * j); f32x4 v = xr[64 * j]; v = v * rs * gg; xr[64 * j] = v; } }
    }
}

extern "C" void kernel_launch(void* const* d_in, const int* in_sizes, int n_in, void* d_out, int out_size, void* d_ws, size_t ws_size, hipStream_t stream) {
    static int grid = 0;
    if (grid == 0) {
        if (n_in != 18 || out_size != T * DM || ws_size < WS_END) { fprintf(stderr, "kernel_launch: unexpected shapes n_in %d out %d ws %zu\n", n_in, out_size, ws_size); grid = -1; return; }
        int dev = 0, cus = 0, per_cu = 0;
        (void)hipGetDevice(&dev); (void)hipDeviceGetAttribute(&cus, hipDeviceAttributeMultiprocessorCount, dev);
        if (hipFuncSetAttribute((const void*)fwd_megakernel, hipFuncAttributeMaxDynamicSharedMemorySize, LDS_BYTES) != hipSuccess) { fprintf(stderr, "hipFuncSetAttribute failed\n"); grid = -1; return; }
        if (hipOccupancyMaxActiveBlocksPerMultiprocessor(&per_cu, (const void*)fwd_megakernel, 512, LDS_BYTES) != hipSuccess || per_cu < 1) { fprintf(stderr, "occupancy query: %d\n", per_cu); per_cu = 1; }
        (void)hipGetLastError();
        grid = cus * per_cu;
        fprintf(stderr, "kernel_launch: grid %d (cus %d x %d)\n", grid, cus, per_cu);
    }
    if (grid < 0) return;
    (void)hipMemsetAsync((char*)d_ws + WS_BAR, 0, XCD_BAR_WORDS * 4, stream);
    Args a{};
    for (int i = 0; i < 18; ++i) a.in[i] = (const float*)d_in[i];
    a.out = (float*)d_out; a.ws = (unsigned char*)d_ws;
#if MK_LAUNCHES == 1
    a.ph_lo = 0; a.ph_hi = 10;
    void* args[] = {&a};
    hipError_t e = hipLaunchCooperativeKernel((const void*)fwd_megakernel, dim3(grid), dim3(512), args, LDS_BYTES, stream);
    if (e != hipSuccess) fprintf(stderr, "cooperative launch failed: %s (grid %d)\n", hipGetErrorString(e), grid);
#else
    for (int k = 0; k < 10; ++k) { a.ph_lo = k; a.ph_hi = k + 1; hipLaunchKernelGGL(fwd_megakernel, dim3(grid), dim3(512), LDS_BYTES, stream, a); }
#endif
}
```

```cpp
#include <hip/hip_runtime.h>
#include <hip/hip_bf16.h>
#include <hip/hip_cooperative_groups.h>
#include <cstdio>
#include <cstdint>
namespace cg = cooperative_groups;

#define LAS __attribute__((address_space(3)))
typedef unsigned short bf16_t;
typedef short bf16x8 __attribute__((ext_vector_type(8)));
typedef short s16x4 __attribute__((ext_vector_type(4)));
typedef float f32x4 __attribute__((ext_vector_type(4)));
typedef float f32x16 __attribute__((ext_vector_type(16)));
typedef unsigned u32x4 __attribute__((ext_vector_type(4)));
typedef unsigned u32x2 __attribute__((ext_vector_type(2)));

constexpr int T = 16384, SEQ = 8192, DM = 2048, FF = 5632, NH = 8, HD = 128;
constexpr int NGU = 2 * FF;
constexpr int NIN = 10496;
constexpr int INC = 10248;
constexpr float EPS = 1e-6f;
constexpr float LOG2E = 1.4426950408889634f;
constexpr float QSCALE = 0.08838834764831845f * LOG2E;

constexpr size_t MiB = 1u << 20;
constexpr size_t WS_SSQ = 0;
constexpr size_t WS_BAR = 512 * 1024;
constexpr size_t WS_ROPE = 1 * MiB;
constexpr size_t WS_LOGF = 2 * MiB;
constexpr size_t WS_WGU = 3 * MiB;
constexpr size_t WS_WD = 47 * MiB;
constexpr size_t WS_WIN = 69 * MiB;
constexpr size_t WS_WP = 110 * MiB;
constexpr size_t WS_WOUT = 118 * MiB;
constexpr size_t WS_XB = 126 * MiB;
constexpr size_t WS_BIG = 190 * MiB;
constexpr size_t WS_GATES = 382 * MiB;
constexpr size_t WS_END = 510 * MiB;

typedef float f32x2_t __attribute__((ext_vector_type(2))); typedef __bf16 bf16x2_t __attribute__((ext_vector_type(2)));
__device__ __forceinline__ unsigned cvt_pk_bf16(float lo, float hi) { f32x2_t v = {lo, hi}; bf16x2_t b = __builtin_convertvector(v, bf16x2_t); return __builtin_bit_cast(unsigned, b); }
__device__ __forceinline__ float bf_lo(unsigned w) { return __uint_as_float(w << 16); }
__device__ __forceinline__ float bf_hi(unsigned w) { return __uint_as_float(w & 0xffff0000u); }
__device__ __forceinline__ float wave_sum(float v) {
#pragma unroll
    for (int o = 1; o < 64; o <<= 1) v += __shfl_xor(v, o);
    return v;
}

namespace pg8 {
constexpr int BM = 256, BK = 64, HALF = 128, HTB = HALF * BK * 2, STAGE_BYTES = 8 * HTB, NXCD = 8, WGM = 8;
__host__ __device__ __forceinline__ int lds_byte(int r, int c) { const int st = (r >> 4) * 2 + (c >> 5), rr = r & 15, cc = c & 31, ob = rr * 64 + cc * 2; return st * 1024 + (ob ^ (((ob >> 9) & 1) << 5)); }
__host__ __device__ __forceinline__ void stage_rc(int b, int& R, int& C) { const int st = b / 1024, sb = b % 1024, swz = sb ^ (((sb >> 9) & 1) << 5); R = (st >> 1) * 16 + swz / 64; C = (st & 1) * 32 + (swz % 64) / 2; }
__host__ __device__ __forceinline__ int perm32(int rho) { const int n = rho >> 4, i = rho & 15; return 8 * (i >> 2) + 4 * n + (i & 3); }

struct Unit { int pm, pn, ko, half; };
struct Gemm { const bf16_t* A; const bf16_t* Bt; int K, lda, ldb; };

struct StaticOrder {
    int nM, nN, nwg, G, c, halves;
    __device__ void init(int M, int N, int G_, int c_, int halves_ = 1) { nM = M / BM; nN = N / BM; nwg = nM * nN; G = G_; c = c_; halves = halves_; }
    __device__ bool next(int i, Unit& u) const {
        const int it = i / halves, hf = i - it * halves;
        const long L = (long)it * G + c; if (L >= nwg) return false;
        int wgid = (int)L; { const int q = nwg / NXCD, r = nwg % NXCD, xcd = wgid % NXCD, off = wgid / NXCD; wgid = (xcd < r ? xcd * (q + 1) : r * (q + 1) + (xcd - r) * q) + off; }
        const int nig = WGM * nN, gid = wgid / nig, fm = gid * WGM, gsz = (nM - fm) < WGM ? (nM - fm) : WGM;
        u.pm = fm + ((wgid % nig) % gsz); u.pn = (wgid % nig) / gsz; u.half = hf; u.ko = hf * 1024; return true;
    }
};

template <class Epi, class Sched>
__device__ __forceinline__ void gemm_phase(LAS unsigned char* lds, const Gemm g, const Sched& S, const Epi& E) {
    int tid_ = threadIdx.x; asm volatile("" : "+v"(tid_));
    const int tid = tid_, wid = __builtin_amdgcn_readfirstlane(tid >> 6), lane = tid & 63, wr = wid >> 2, wc = wid & 3, fr = lane & 15, fq = lane >> 4;
    const int nt = g.K / BK;
    unsigned voffA[2], voffB[2];
#pragma unroll
    for (int i = 0; i < 2; ++i) { int R, C; stage_rc(tid * 16 + i * 8192, R, C); const int Rb = (R & ~31) + perm32(R & 31);
        voffA[i] = (unsigned)(R * g.lda + C) * 2u; voffB[i] = (unsigned)(Rb * g.ldb + C) * 2u; }
    const size_t kstep = (size_t)(BK * 2);
    const size_t hstepA = (size_t)HALF * g.lda * 2, hstepB = (size_t)HALF * g.ldb * 2;
    const size_t tstepA = 2 * hstepA, tstepB = 2 * hstepB;
    const unsigned ldsw = (unsigned)wid * 1024u;
    const int aoff = lds_byte(wr * 64 + fr, fq * 8), boff = lds_byte(wc * 32 + fr, fq * 8);
#define PG8_SA(b, h) (((b) * 2 + (h)) * HTB)
#define PG8_SB(b, h) ((4 + (b) * 2 + (h)) * HTB)
#define PG8_STAGE(bufoff, gbase, voff) do { _Pragma("unroll") for (int _i = 0; _i < 2; ++_i) \
        __builtin_amdgcn_global_load_lds((const unsigned*)((const char*)(gbase) + (voff)[_i]), (LAS unsigned*)(lds + (bufoff) + ldsw + _i * 8192), 16, 0, 0); } while (0)
#define PG8_LDA(dst, b, h) do { _Pragma("unroll") for (int m = 0; m < 4; ++m) _Pragma("unroll") for (int k = 0; k < 2; ++k) dst[m][k] = *(const LAS bf16x8*)(lds + PG8_SA(b, h) + aoff + m * 2048 + k * 1024); } while (0)
#define PG8_LDB(dst, b, h) do { _Pragma("unroll") for (int n = 0; n < 2; ++n) _Pragma("unroll") for (int k = 0; k < 2; ++k) dst[n][k] = *(const LAS bf16x8*)(lds + PG8_SB(b, h) + boff + n * 2048 + k * 1024); } while (0)
#define PG8_MMA(ai, bj, At, Bt) do { __builtin_amdgcn_s_setprio(1); _Pragma("unroll") for (int m = 0; m < 4; ++m) _Pragma("unroll") for (int n = 0; n < 2; ++n) _Pragma("unroll") for (int k = 0; k < 2; ++k) \
        acc[ai][bj][m][n] = __builtin_amdgcn_mfma_f32_16x16x32_bf16(Bt[n][k], At[m][k], acc[ai][bj][m][n], 0, 0, 0); __builtin_amdgcn_s_setprio(0); } while (0)
#define PG8_WAIT_V(n) asm volatile("s_waitcnt vmcnt(" #n ")" ::: "memory")
#define PG8_WAIT_L(n) asm volatile("s_waitcnt lgkmcnt(" #n ")" ::: "memory")
#define PG8_BAR __builtin_amdgcn_s_barrier()
#define PG8_SCHED __builtin_amdgcn_sched_barrier(0)
    Unit cur, nxt; int ui = 0;
    if (!S.next(0, cur)) return;
    constexpr int RELAX = (8 + Epi::STORES) > 63 ? 63 : (8 + Epi::STORES);
#define PG8_WAIT_V8F do { if (Epi::STORES > 0 && t == 0) asm volatile("s_waitcnt vmcnt(%0)" :: "i"(RELAX) : "memory"); else asm volatile("s_waitcnt vmcnt(8)" ::: "memory"); } while (0)
    f32x4 acc[2][2][4][2];
#pragma unroll
    for (int a = 0; a < 2; ++a)
#pragma unroll
        for (int b = 0; b < 2; ++b)
#pragma unroll
            for (int m = 0; m < 4; ++m)
#pragma unroll
                for (int n = 0; n < 2; ++n) acc[a][b][m][n] = (f32x4){0.f, 0.f, 0.f, 0.f};
    bf16x8 At[4][2], B0[2][2], B1[2][2];
    const char* cA = (const char*)g.A + (size_t)cur.pm * tstepA + (size_t)cur.ko * 2; const char* cB = (const char*)g.Bt + (size_t)cur.pn * tstepB + (size_t)cur.ko * 2;
    PG8_STAGE(PG8_SB(0, 0), cB, voffB); PG8_STAGE(PG8_SB(0, 1), cB + hstepB, voffB); PG8_STAGE(PG8_SA(0, 0), cA, voffA); PG8_STAGE(PG8_SA(0, 1), cA + hstepA, voffA);
    if (wr == 1) PG8_BAR;
    PG8_WAIT_V(2); PG8_BAR;
    PG8_STAGE(PG8_SB(1, 0), cB + kstep, voffB); PG8_STAGE(PG8_SA(1, 0), cA + kstep, voffA); PG8_STAGE(PG8_SB(1, 1), cB + hstepB + kstep, voffB);
    if (Epi::STORES > 0) { PG8_WAIT_V(0); } else { PG8_WAIT_V(6); } PG8_BAR;
    for (;;) {
        const bool has_next = S.next(ui + 1, nxt);
        const char* nA = has_next ? (const char*)g.A + (size_t)nxt.pm * tstepA + (size_t)nxt.ko * 2 : cA; const char* nB = has_next ? (const char*)g.Bt + (size_t)nxt.pn * tstepB + (size_t)nxt.ko * 2 : cB;
        for (int t = 0; t < nt; t += 2) {
            const bool last = (t == nt - 2);
            const char* a1 = cA + (size_t)(t + 1) * kstep;
            const char* a2 = last ? nA : cA + (size_t)(t + 2) * kstep; const char* b2 = last ? nB : cB + (size_t)(t + 2) * kstep;
            const char* a3 = a2 + kstep; const char* b3 = b2 + kstep;
            PG8_LDB(B0, 0, 0); PG8_LDB(B1, 0, 1); PG8_SCHED; PG8_LDA(At, 0, 0); PG8_STAGE(PG8_SA(1, 1), a1 + hstepA, voffA);
            PG8_WAIT_V8F; PG8_WAIT_L(0); PG8_BAR; PG8_MMA(0, 0, At, B0); PG8_MMA(0, 1, At, B1); PG8_BAR; PG8_SCHED;
            PG8_LDA(At, 0, 1); PG8_STAGE(PG8_SB(0, 0), b2, voffB); PG8_STAGE(PG8_SB(0, 1), b2 + hstepB, voffB); PG8_STAGE(PG8_SA(0, 0), a2, voffA);
            PG8_WAIT_V8F; PG8_WAIT_L(0); PG8_BAR; PG8_MMA(1, 0, At, B0); PG8_MMA(1, 1, At, B1); PG8_BAR; PG8_SCHED;
            PG8_LDB(B0, 1, 0); PG8_LDB(B1, 1, 1); PG8_SCHED; PG8_LDA(At, 1, 0); PG8_STAGE(PG8_SA(0, 1), a2 + hstepA, voffA);
            PG8_WAIT_V(8); PG8_WAIT_L(0); PG8_BAR; PG8_MMA(0, 0, At, B0); PG8_MMA(0, 1, At, B1); PG8_BAR; PG8_SCHED;
            PG8_LDA(At, 1, 1); PG8_STAGE(PG8_SB(1, 0), b3, voffB); PG8_STAGE(PG8_SB(1, 1), b3 + hstepB, voffB); PG8_STAGE(PG8_SA(1, 0), a3, voffA);
            PG8_WAIT_V(8); PG8_WAIT_L(0); PG8_BAR; PG8_MMA(1, 0, At, B0); PG8_MMA(1, 1, At, B1); PG8_BAR; PG8_SCHED;
        }
        if (wr == 0) PG8_BAR;
        E(acc, cur, wr, wc, fr, fq);
        if (!has_next) break;
#pragma unroll
        for (int a = 0; a < 2; ++a)
#pragma unroll
            for (int b = 0; b < 2; ++b)
#pragma unroll
                for (int m = 0; m < 4; ++m)
#pragma unroll
                    for (int n = 0; n < 2; ++n) acc[a][b][m][n] = (f32x4){0.f, 0.f, 0.f, 0.f};
        cur = nxt; cA = nA; cB = nB; ++ui;
        if (wr == 1) PG8_BAR;
    }
    PG8_WAIT_V(0);
    PG8_BAR;
#undef PG8_SA
#undef PG8_SB
#undef PG8_STAGE
#undef PG8_LDA
#undef PG8_LDB
#undef PG8_MMA
#undef PG8_WAIT_V
#undef PG8_WAIT_L
#undef PG8_BAR
#undef PG8_SCHED
}

typedef const f32x4 (&AccRef)[2][2][4][2];

__device__ __forceinline__ float rstd_of(const float* ssq, int r) { return rsqrtf(ssq[r] * (1.f / (float)DM) + EPS); }
__device__ __forceinline__ float silu_mul(float g, float u) { return g * __builtin_amdgcn_rcpf(1.f + __builtin_amdgcn_exp2f(-g * LOG2E)) * u; }
__device__ __forceinline__ float sigmoidf_(float z) { return __builtin_amdgcn_rcpf(1.f + __builtin_amdgcn_exp2f(-z * LOG2E)); }

struct EpiSwiGLU {
    static constexpr int STORES = 8;
    bf16_t* O; const float* ssq;
    __device__ __forceinline__ void operator()(AccRef acc, const Unit& u, int wr, int wc, int fr, int fq) const {
        const int row0 = u.pm * BM + wr * 64 + fr, col = u.pn * HALF + wc * 32 + 8 * fq;
        float rsv[8];
#pragma unroll
        for (int i = 0; i < 8; ++i) rsv[i] = ssq[row0 + (i >> 2) * HALF + (i & 3) * 16];
#pragma unroll
        for (int i = 0; i < 8; ++i) rsv[i] = rsqrtf(rsv[i] * (1.f / (float)DM) + EPS);
#pragma unroll
        for (int ai = 0; ai < 2; ++ai)
#pragma unroll
            for (int m = 0; m < 4; ++m) { const int r = row0 + ai * HALF + m * 16; const float rs = rsv[ai * 4 + m];
                const f32x4 g0 = acc[ai][0][m][0] * rs, g1 = acc[ai][0][m][1] * rs, u0 = acc[ai][1][m][0] * rs, u1 = acc[ai][1][m][1] * rs;
                u32x4 w; w.x = cvt_pk_bf16(silu_mul(g0[0], u0[0]), silu_mul(g0[1], u0[1])); w.y = cvt_pk_bf16(silu_mul(g0[2], u0[2]), silu_mul(g0[3], u0[3]));
                w.z = cvt_pk_bf16(silu_mul(g1[0], u1[0]), silu_mul(g1[1], u1[1])); w.w = cvt_pk_bf16(silu_mul(g1[2], u1[2]), silu_mul(g1[3], u1[3]));
                *(u32x4*)(O + (size_t)r * FF + col) = w; }
    }
};
struct EpiResid {
    static constexpr int STORES = 40;
    const float* resid; float* out; bf16_t* xb; float* ssq; float alpha;
    __device__ __forceinline__ void operator()(AccRef acc, const Unit& u, int wr, int wc, int fr, int fq) const {
        const int row0 = u.pm * BM + wr * 64 + fr, col0 = u.pn * BM + wc * 32 + 8 * fq;
        f32x4 cur[4], nxt[4];
        { const size_t off = (size_t)row0 * DM + col0; cur[0] = *(const f32x4*)(resid + off); cur[1] = *(const f32x4*)(resid + off + 4); cur[2] = *(const f32x4*)(resid + off + HALF); cur[3] = *(const f32x4*)(resid + off + HALF + 4); }
#pragma unroll
        for (int i = 0; i < 8; ++i) { const int ai = i >> 2, m = i & 3; const int r = row0 + ai * HALF + m * 16; float sq = 0.f;
            if (i < 7) { const int rn = row0 + ((i + 1) >> 2) * HALF + ((i + 1) & 3) * 16; const size_t off = (size_t)rn * DM + col0;
                nxt[0] = *(const f32x4*)(resid + off); nxt[1] = *(const f32x4*)(resid + off + 4); nxt[2] = *(const f32x4*)(resid + off + HALF); nxt[3] = *(const f32x4*)(resid + off + HALF + 4); }
            asm volatile("" ::: "memory");
#pragma unroll
            for (int bj = 0; bj < 2; ++bj) { const size_t off = (size_t)r * DM + col0 + bj * HALF;
                const f32x4 o0 = cur[2 * bj] + acc[ai][bj][m][0] * alpha, o1 = cur[2 * bj + 1] + acc[ai][bj][m][1] * alpha;
                *(f32x4*)(out + off) = o0; *(f32x4*)(out + off + 4) = o1;
                sq += (o0[0] * o0[0] + o0[1] * o0[1]) + (o0[2] * o0[2] + o0[3] * o0[3]) + (o1[0] * o1[0] + o1[1] * o1[1]) + (o1[2] * o1[2] + o1[3] * o1[3]);
                if (xb) { u32x4 w; w.x = cvt_pk_bf16(o0[0], o0[1]); w.y = cvt_pk_bf16(o0[2], o0[3]); w.z = cvt_pk_bf16(o1[0], o1[1]); w.w = cvt_pk_bf16(o1[2], o1[3]); *(u32x4*)(xb + off) = w; } }
            sq += __shfl_xor(sq, 16); sq += __shfl_xor(sq, 32);
            if (fq == 0) atomicAdd(ssq + r, sq);
#pragma unroll
            for (int k = 0; k < 4; ++k) cur[k] = nxt[k]; }
    }
};
struct EpiWin {
    static constexpr int STORES = 0;
    bf16_t* qkv; bf16_t* gates; float* logf; const float* ssq; const float* rope; const float* b_forget; const float* b_gd; const float* b_gf;
    __device__ __forceinline__ void operator()(AccRef acc, const Unit& u, int wr, int wc, int fr, int fq) const {
        const int row0 = u.pm * BM + wr * 64 + fr, pn = u.pn;
        float rsv[8];
#pragma unroll
        for (int i = 0; i < 8; ++i) rsv[i] = ssq[row0 + (i >> 2) * HALF + (i & 3) * 16];
#pragma unroll
        for (int i = 0; i < 8; ++i) rsv[i] = rsqrtf(rsv[i] * (1.f / (float)DM) + EPS);
        if (pn < 24) {
            const int which = pn >> 2; const bool rot = (which < 2) && (wc == 0); const float qs = (which == 0 || which == 3) ? QSCALE : 1.f;
            bf16_t* base = qkv + (size_t)which * ((size_t)T * 1024);
            f32x4 cs0 = {1.f, 0.f, 1.f, 0.f}, cs1 = {1.f, 0.f, 1.f, 0.f}, ns0 = cs0, ns1 = cs1;
            if (rot) { const int s0 = row0 & (SEQ - 1); cs0 = *(const f32x4*)(rope + ((size_t)s0 * 16 + 4 * fq) * 2); cs1 = *(const f32x4*)(rope + ((size_t)s0 * 16 + 4 * fq) * 2 + 4); }
#pragma unroll
            for (int i = 0; i < 8; ++i) { const int ai = i >> 2, m = i & 3; const int r = row0 + ai * HALF + m * 16; const float rs = rsv[i] * qs; const int b = r >> 13, sp = r & (SEQ - 1);
                if (rot && i < 7) { const int sn = (row0 + ((i + 1) >> 2) * HALF + ((i + 1) & 3) * 16) & (SEQ - 1);
                    ns0 = *(const f32x4*)(rope + ((size_t)sn * 16 + 4 * fq) * 2); ns1 = *(const f32x4*)(rope + ((size_t)sn * 16 + 4 * fq) * 2 + 4); }
                asm volatile("" ::: "memory");
#pragma unroll
                for (int bj = 0; bj < 2; ++bj) { const int head = 2 * (pn & 3) + bj;
                    f32x4 v0 = acc[ai][bj][m][0] * rs, v1 = acc[ai][bj][m][1] * rs;
                    if (rot) { f32x4 t0, t1;
                        t0[0] = v0[0] * cs0[0] - v0[1] * cs0[1]; t0[1] = v0[1] * cs0[0] + v0[0] * cs0[1]; t0[2] = v0[2] * cs0[2] - v0[3] * cs0[3]; t0[3] = v0[3] * cs0[2] + v0[2] * cs0[3];
                        t1[0] = v1[0] * cs1[0] - v1[1] * cs1[1]; t1[1] = v1[1] * cs1[0] + v1[0] * cs1[1]; t1[2] = v1[2] * cs1[2] - v1[3] * cs1[3]; t1[3] = v1[3] * cs1[2] + v1[2] * cs1[3];
                        v0 = t0; v1 = t1; }
                    u32x4 w; w.x = cvt_pk_bf16(v0[0], v0[1]); w.y = cvt_pk_bf16(v0[2], v0[3]); w.z = cvt_pk_bf16(v1[0], v1[1]); w.w = cvt_pk_bf16(v1[2], v1[3]);
                    *(u32x4*)(base + ((size_t)(b * NH + head) * SEQ + sp) * HD + wc * 32 + 8 * fq) = w; }
                cs0 = ns0; cs1 = ns1; }
        } else {
            const int gi = (pn - 24) >> 3, ct = (pn - 24) & 7; const float* bias = gi ? b_gf : b_gd; bf16_t* gb = gates + (size_t)gi * ((size_t)T * DM);
            const int col0 = ct * BM + wc * 32 + 8 * fq;
            f32x4 bv[2][2];
#pragma unroll
            for (int bj = 0; bj < 2; ++bj) { bv[bj][0] = *(const f32x4*)(bias + col0 + bj * HALF); bv[bj][1] = *(const f32x4*)(bias + col0 + bj * HALF + 4); }
#pragma unroll
            for (int ai = 0; ai < 2; ++ai)
#pragma unroll
                for (int m = 0; m < 4; ++m) { const int r = row0 + ai * HALF + m * 16; const float rs = rsv[ai * 4 + m];
#pragma unroll
                    for (int bj = 0; bj < 2; ++bj) { const f32x4 v0 = acc[ai][bj][m][0] * rs + bv[bj][0], v1 = acc[ai][bj][m][1] * rs + bv[bj][1];
                        u32x4 w; w.x = cvt_pk_bf16(sigmoidf_(v0[0]), sigmoidf_(v0[1])); w.y = cvt_pk_bf16(sigmoidf_(v0[2]), sigmoidf_(v0[3]));
                        w.z = cvt_pk_bf16(sigmoidf_(v1[0]), sigmoidf_(v1[1])); w.w = cvt_pk_bf16(sigmoidf_(v1[2]), sigmoidf_(v1[3]));
                        *(u32x4*)(gb + (size_t)r * DM + col0 + bj * HALF) = w; } }
        }
    }
};
struct EpiProj {
    static constexpr int STORES = 16;
    const bf16_t* gates; bf16_t* merged;
    __device__ __forceinline__ void operator()(AccRef acc, const Unit& u, int wr, int wc, int fr, int fq) const {
        const int row0 = u.pm * BM + wr * 64 + fr, col0 = u.pn * BM + wc * 32 + 8 * fq;
        const bf16_t* gb = gates + (size_t)u.half * ((size_t)T * DM);
        const u32x4 zz = {0u, 0u, 0u, 0u};
        u32x4 cg[2], cp[2] = {zz, zz}, ng[2], np[2] = {zz, zz};
        { const size_t off = (size_t)row0 * DM + col0; cg[0] = *(const u32x4*)(gb + off); cg[1] = *(const u32x4*)(gb + off + HALF);
          if (u.half) { cp[0] = *(const u32x4*)(merged + off); cp[1] = *(const u32x4*)(merged + off + HALF); } }
#pragma unroll
        for (int i = 0; i < 8; ++i) { const int ai = i >> 2, m = i & 3; const int r = row0 + ai * HALF + m * 16;
            if (i < 7) { const int rn = row0 + ((i + 1) >> 2) * HALF + ((i + 1) & 3) * 16; const size_t off = (size_t)rn * DM + col0;
                ng[0] = *(const u32x4*)(gb + off); ng[1] = *(const u32x4*)(gb + off + HALF);
                if (u.half) { np[0] = *(const u32x4*)(merged + off); np[1] = *(const u32x4*)(merged + off + HALF); } }
            asm volatile("" ::: "memory");
#pragma unroll
            for (int bj = 0; bj < 2; ++bj) { const size_t off = (size_t)r * DM + col0 + bj * HALF;
                const u32x4 gv = cg[bj], pv = cp[bj];
                f32x4 v0 = acc[ai][bj][m][0], v1 = acc[ai][bj][m][1];
                v0[0] *= bf_lo(gv.x); v0[1] *= bf_hi(gv.x); v0[2] *= bf_lo(gv.y); v0[3] *= bf_hi(gv.y);
                v1[0] *= bf_lo(gv.z); v1[1] *= bf_hi(gv.z); v1[2] *= bf_lo(gv.w); v1[3] *= bf_hi(gv.w);
                if (u.half) {
                    v0[0] += bf_lo(pv.x); v0[1] += bf_hi(pv.x); v0[2] += bf_lo(pv.y); v0[3] += bf_hi(pv.y);
                    v1[0] += bf_lo(pv.z); v1[1] += bf_hi(pv.z); v1[2] += bf_lo(pv.w); v1[3] += bf_hi(pv.w); }
                u32x4 w; w.x = cvt_pk_bf16(v0[0], v0[1]); w.y = cvt_pk_bf16(v0[2], v0[3]); w.z = cvt_pk_bf16(v1[0], v1[1]); w.w = cvt_pk_bf16(v1[2], v1[3]);
                *(u32x4*)(merged + off) = w; }
            cg[0] = ng[0]; cg[1] = ng[1]; cp[0] = np[0]; cp[1] = np[1]; }
    }
};
}

namespace att {
using bf16 = __hip_bfloat16;
constexpr int D = 128, NW = 8, QBLK = 32, KVBLK = 64, QB = NW * QBLK, LDO = 2048;
constexpr int SHM_V = KVBLK * D * 2, SHM_K = KVBLK * D * 2;
constexpr int LDS_WSF = 2 * SHM_V + 2 * SHM_K;
constexpr int LDS_CB = LDS_WSF + 2048;
constexpr int LDS_DT = LDS_CB + 32768;
constexpr int DT_N = 2624, DT_OFF = 320;
constexpr int LDS_SCAN = LDS_DT + DT_N * 4;
constexpr int LDS_END = LDS_SCAN + 64;
constexpr float THR2 = 11.5f;

#define KSWZ(row, colB) ((row) * 256 + ((colB) ^ (((row) & 7) << 4)))
#define SBAR() __builtin_amdgcn_sched_barrier(0)
__device__ __forceinline__ int v_st(int k, int c) { const int kk = (k & ~0xC) | ((k & 4) << 1) | ((k & 8) >> 1); return ((kk >> 3) * 4 + (c >> 5)) * 512 + ((kk & 7) * 32 + (c & 31)) * 2; }
__device__ __forceinline__ int v_rd_base(int lane) { return ((lane & 3) << 3) | (((lane >> 2) & 3) << 6) | (((lane >> 4) & 1) << 5) | (((lane >> 5) & 1) << 8); }
constexpr int v_rd_off(int d0, int ks, int half) { return d0 * 512 + ks * 4096 + half * 2048; }
__device__ __forceinline__ int crow(int r, int hi) { return (r & 3) + 8 * (r >> 2) + 4 * hi; }
__device__ __forceinline__ unsigned cvtpk(float lo, float hi) { unsigned r; asm volatile("v_cvt_pk_bf16_f32 %0, %1, %2" : "=v"(r) : "v"(lo), "v"(hi)); return r; }
__device__ __forceinline__ bf16x8 load8(const bf16* p) { return *reinterpret_cast<const bf16x8*>(p); }
__device__ __forceinline__ void mask_tile(f32x16& p0, f32x16& p1, int dq, unsigned W) {
    const float NEG = -__builtin_inff();
#pragma unroll
    for (int r = 0; r < 16; ++r) { const int c = (r & 3) + 8 * (r >> 2);
        if ((unsigned)(dq - c) >= W) p0[r] = NEG;
        if ((unsigned)(dq - c - 32) >= W) p1[r] = NEG; }
}
__device__ __forceinline__ void partialSM(f32x16& p0, f32x16& p1, float& m_reg, float& mn, float& alpha) {
    float pmax = p0[0];
#pragma unroll
    for (int r = 1; r < 16; ++r) pmax = fmaxf(pmax, p0[r]);
#pragma unroll
    for (int r = 0; r < 16; ++r) pmax = fmaxf(pmax, p1[r]);
    { auto rr = __builtin_amdgcn_permlane32_swap(__float_as_uint(pmax), __float_as_uint(pmax), false, false);
      pmax = fmaxf(__uint_as_float(rr[0]), __uint_as_float(rr[1])); }
    if (__builtin_expect(__all((pmax - m_reg) <= THR2), 1)) { mn = m_reg; alpha = 1.f; }
    else { mn = fmaxf(m_reg, pmax); alpha = __builtin_amdgcn_exp2f(m_reg - mn); m_reg = mn; }
#pragma unroll
    for (int r = 0; r < 16; ++r) p0[r] = p0[r] - mn;
#pragma unroll
    for (int r = 0; r < 16; ++r) p1[r] = p1[r] - mn;
#pragma unroll
    for (int r = 0; r < 16; ++r) p0[r] = __builtin_amdgcn_exp2f(p0[r]);
}
__device__ __forceinline__ void finishSM(f32x16& p0, f32x16& p1, float alpha, float& l_reg, bf16x8& pa0, bf16x8& pa1, bf16x8& pa2, bf16x8& pa3) {
#pragma unroll
    for (int r = 0; r < 16; ++r) p1[r] = __builtin_amdgcn_exp2f(p1[r]);
    float ps = 0;
#pragma unroll
    for (int r = 0; r < 16; ++r) ps += p0[r];
#pragma unroll
    for (int r = 0; r < 16; ++r) ps += p1[r];
    { auto rr = __builtin_amdgcn_permlane32_swap(__float_as_uint(ps), __float_as_uint(ps), false, false);
      ps = __uint_as_float(rr[0]) + __uint_as_float(rr[1]); }
    l_reg = l_reg * alpha + ps;
#define PK4(P, B_, OUT) do { unsigned a0 = cvtpk(P[B_+0], P[B_+1]), a1 = cvtpk(P[B_+2], P[B_+3]);                          \
        unsigned b0 = cvtpk(P[B_+4], P[B_+5]), b1 = cvtpk(P[B_+6], P[B_+7]);                                             \
        auto r0 = __builtin_amdgcn_permlane32_swap(a0, b0, false, false); auto r1 = __builtin_amdgcn_permlane32_swap(a1, b1, false, false); \
        u32x4 w = {r0[0], r1[0], r0[1], r1[1]}; OUT = *reinterpret_cast<bf16x8*>(&w); } while (0)
    PK4(p0, 0, pa0); PK4(p0, 8, pa1); PK4(p1, 0, pa2); PK4(p1, 8, pa3);
#undef PK4
}
template <int KB, int MODE>
__device__ __forceinline__ void qkt(f32x16& p0, f32x16& p1, const char* K_lds, int r32, int hi, const bf16x8* qr, const LAS float* cbt, const LAS float* dtab, int kb_, int qm) {
    if (MODE == 0) { const LAS float* cb_ = cbt + (kb_ + 4 * hi);
#pragma unroll
        for (int j_ = 0; j_ < 4; ++j_) { const f32x4 a_ = *(const LAS f32x4*)(cb_ + 8 * j_), b_ = *(const LAS f32x4*)(cb_ + 32 + 8 * j_);
            p0[4 * j_ + 0] = a_[0]; p0[4 * j_ + 1] = a_[1]; p0[4 * j_ + 2] = a_[2]; p0[4 * j_ + 3] = a_[3]; p1[4 * j_ + 0] = b_[0]; p1[4 * j_ + 1] = b_[1]; p1[4 * j_ + 2] = b_[2]; p1[4 * j_ + 3] = b_[3]; } }
    else { const LAS float* tb_ = dtab + (qm - kb_ + (DT_OFF - 59));
#pragma unroll
        for (int r_ = 0; r_ < 16; ++r_) { const int c_ = (r_ & 3) + 8 * (r_ >> 2); p0[r_] = tb_[59 - c_]; p1[r_] = tb_[27 - c_]; } }
    const char* kb[4];
#pragma unroll
    for (int dd = 0; dd < 4; ++dd) kb[dd] = K_lds + KB * SHM_K + KSWZ(r32, (dd * 16 + hi * 8) * 2);
#pragma unroll
    for (int d0 = 0; d0 < 8; ++d0) { const char* a = kb[d0 & 3] + (d0 >> 2) * 128;
        bf16x8 b0 = *reinterpret_cast<const bf16x8*>(a);
        bf16x8 b1 = *reinterpret_cast<const bf16x8*>(a + 32 * 256);
        p0 = __builtin_amdgcn_mfma_f32_32x32x16_bf16(b0, qr[d0], p0, 0, 0, 0);
        p1 = __builtin_amdgcn_mfma_f32_32x32x16_bf16(b1, qr[d0], p1, 0, 0, 0); }
}
template <int VB>
__device__ __forceinline__ void pv_tile(f32x16* o, int vb0, bf16x8 pa0, bf16x8 pa1, bf16x8 pa2, bf16x8 pa3) {
#define TRRD(dst, off) asm volatile("ds_read_b64_tr_b16 %0, %1 offset:%2" : "=&v"(dst) : "v"(vb0), "i"(off) : "memory")
#define PV_D0(d0) do { s16x4 l0, l1, l2, l3, h0, h1, h2, h3; constexpr int b_ = VB * SHM_V + v_rd_off(d0, 0, 0); \
        TRRD(l0, b_); TRRD(h0, b_ + 2048); TRRD(l1, b_ + 4096); TRRD(h1, b_ + 6144); TRRD(l2, b_ + 8192); TRRD(h2, b_ + 10240); TRRD(l3, b_ + 12288); TRRD(h3, b_ + 14336); \
        asm volatile("s_waitcnt lgkmcnt(0)" ::: "memory"); SBAR();   \
        o[d0] = __builtin_amdgcn_mfma_f32_32x32x16_bf16(pa0, (bf16x8){l0[0], l0[1], l0[2], l0[3], h0[0], h0[1], h0[2], h0[3]}, o[d0], 0, 0, 0);   \
        o[d0] = __builtin_amdgcn_mfma_f32_32x32x16_bf16(pa1, (bf16x8){l1[0], l1[1], l1[2], l1[3], h1[0], h1[1], h1[2], h1[3]}, o[d0], 0, 0, 0);   \
        o[d0] = __builtin_amdgcn_mfma_f32_32x32x16_bf16(pa2, (bf16x8){l2[0], l2[1], l2[2], l2[3], h2[0], h2[1], h2[2], h2[3]}, o[d0], 0, 0, 0);   \
        o[d0] = __builtin_amdgcn_mfma_f32_32x32x16_bf16(pa3, (bf16x8){l3[0], l3[1], l3[2], l3[3], h3[0], h3[1], h3[2], h3[3]}, o[d0], 0, 0, 0); } while (0)
    PV_D0(0); PV_D0(1); PV_D0(2); PV_D0(3);
#undef PV_D0
#undef TRRD
}

struct BlockRef { const bf16* Q; const bf16* K; const bf16* V; bf16* O; int P0; int W; };
struct Seam { bf16x8 qr[8]; bf16x8 st_v0, st_v1, st_k0, st_k1; };
__device__ __forceinline__ int swa_jlo(int P0, int W) { const int lowk = P0 - W + 1; return lowk > 0 ? lowk / KVBLK : 0; }
#define ROW(p, k0, rr) ((p) + (size_t)((k0) + (rr)) * D + sc)
#define VMW() asm volatile("s_waitcnt vmcnt(0)" ::: "memory")
#define VMWN(n) asm volatile("s_waitcnt vmcnt(%0)" :: "i"(n) : "memory")
#define SLOAD_H(Kp, Vp, k0) do { S.st_v0 = load8(ROW(Vp, k0, sr)); S.st_v1 = load8(ROW(Vp, k0, 32 + sr));              \
                         S.st_k0 = load8(ROW(Kp, k0, sr)); S.st_k1 = load8(ROW(Kp, k0, 32 + sr)); } while (0)
#define SWRITE_HK(bf) do { *(bf16x8*)(K_lds + (bf) * SHM_K + kws) = S.st_k0; *(bf16x8*)(K_lds + (bf) * SHM_K + kws + 32 * 256) = S.st_k1; } while (0)
#define SWRITE_HV(bf) do { *(bf16x8*)(V_lds + (bf) * SHM_V + vst0) = S.st_v0; *(bf16x8*)(V_lds + (bf) * SHM_V + vst1) = S.st_v1; } while (0)
#define SWRITE_H(bf) do { SWRITE_HV(bf); SWRITE_HK(bf); } while (0)
template <int MODE>
__device__ __forceinline__ void attn_prime(const BlockRef& cur, char* lds, Seam& S) {
    int tid_ = threadIdx.x; asm volatile("" : "+v"(tid_));
    const int tid = tid_, wid = __builtin_amdgcn_readfirstlane(tid >> 6), lane = tid & 63, r32 = lane & 31, hi = lane >> 5;
    const int sr = tid >> 4, sc = (tid & 15) * 8, kws = KSWZ(sr, sc * 2); char* K_lds = lds + 2 * SHM_V;
    const int kb0 = MODE == 0 ? cur.P0 + QB - KVBLK : swa_jlo(cur.P0, cur.W) * KVBLK;
#pragma unroll
    for (int d0 = 0; d0 < 8; ++d0) S.qr[d0] = load8(cur.Q + (size_t)(wid * QBLK + r32) * D + d0 * 16 + hi * 8);
    SLOAD_H(cur.K, cur.V, kb0); VMW(); SWRITE_HK(0);
    __syncthreads();
}
template <int MODE>
__device__ __forceinline__ void attn_block(const BlockRef& cur, const BlockRef& nxt, char* lds, const LAS float* cbt, const LAS float* dtab, Seam& S) {
    int tid_ = threadIdx.x; asm volatile("" : "+v"(tid_));
    const int tid = tid_, wid = __builtin_amdgcn_readfirstlane(tid >> 6), lane = tid & 63, r32 = lane & 31, hi = lane >> 5;
    const int W = cur.W;
    const int j_lo = swa_jlo(cur.P0, W);
    const int j_hi = (cur.P0 + QB - 1) / KVBLK + 1;
    const int NT = j_hi - j_lo;
    const int kbn = MODE == 0 ? nxt.P0 + QB - KVBLK : swa_jlo(nxt.P0, nxt.W) * KVBLK;
    const int qlo = cur.P0 + wid * QBLK, qm = qlo + r32 - 4 * hi;
    char* V_lds = lds; char* K_lds = lds + 2 * SHM_V;
    float* ws = (float*)(lds + LDS_WSF) + wid * 64; float* li_l = ws, * al_l = ws + 32;
    float m_reg = -1e30f, l_reg = 0; f32x16 o[4] = {};
    const int sr = tid >> 4, sc = (tid & 15) * 8, vst0 = v_st(sr, sc), vst1 = v_st(32 + sr, sc), kws = KSWZ(sr, sc * 2);
    const int vb0 = (int)(uintptr_t)V_lds + v_rd_base(lane);
    const bf16* Kh = cur.K; const bf16* Vh = cur.V;
#define RESC(a) do { if (__any((a) < 1.f)) { if (hi == 0) al_l[r32] = (a); asm volatile("s_waitcnt lgkmcnt(0)" ::: "memory");              \
                     for (int d_ = 0; d_ < 4; ++d_) for (int r = 0; r < 16; ++r) o[d_][r] *= al_l[crow(r, hi)]; } } while (0)
#define KBASE(t) ((MODE == 0 ? (j_hi - 1 - (t)) : (j_lo + (t))) * KVBLK)
#define MASKT(P0_, P1_, t) do { if (MODE == 0) { const int kb_ = KBASE(t); if (kb_ + KVBLK - 1 > qlo) mask_tile(P0_, P1_, qm - kb_, (unsigned)W); } } while (0)
    constexpr int NQL = 8;
#define SEAM_K0() do { VMWN(NQL); SWRITE_HK(0); SBAR(); } while (0)
    f32x16 pA0, pA1, pB0, pB1; float mnA, mnB, alA, alB; bf16x8 pa0, pa1, pa2, pa3;
    SWRITE_HV(0); SBAR();
    if (NT > 1) { SLOAD_H(Kh, Vh, KBASE(1)); }
    SBAR(); qkt<0, MODE>(pA0, pA1, K_lds, r32, hi, S.qr, cbt, dtab, KBASE(0), qm);
    MASKT(pA0, pA1, 0); partialSM(pA0, pA1, m_reg, mnA, alA);
    if (NT > 1) { VMW(); SWRITE_H(1); }
    __syncthreads();
#define HALF_STEP(PX0, PX1, mnX, alX, PY0, PY1, alY, t, KB, VB, SB) do {                                                      \
        SBAR(); qkt<KB, MODE>(PX0, PX1, K_lds, r32, hi, S.qr, cbt, dtab, KBASE(t), qm);                                             \
        finishSM(PY0, PY1, alY, l_reg, pa0, pa1, pa2, pa3); SBAR();                                                           \
        if ((t) + 1 < NT) { SLOAD_H(Kh, Vh, KBASE((t) + 1)); SBAR(); }                                               \
        pv_tile<VB>(o, vb0, pa0, pa1, pa2, pa3); MASKT(PX0, PX1, (t)); partialSM(PX0, PX1, m_reg, mnX, alX);                                        \
        __syncthreads();                                                                                                      \
        if ((t) + 1 < NT) { VMW(); SWRITE_H(SB); }                                                                          \
        RESC(alX); __syncthreads(); } while (0)
    for (int t = 1; t + 1 < NT; t += 2) {
        HALF_STEP(pB0, pB1, mnB, alB, pA0, pA1, alA, t, 1, 0, 0);
        HALF_STEP(pA0, pA1, mnA, alA, pB0, pB1, alB, t + 1, 0, 1, 1);
    }
    const bool even = (NT & 1) == 0;
    if (even) { SBAR(); qkt<1, MODE>(pB0, pB1, K_lds, r32, hi, S.qr, cbt, dtab, KBASE(NT - 1), qm); SBAR(); }
    SLOAD_H(nxt.K, nxt.V, kbn); SBAR();
#pragma unroll
    for (int d0 = 0; d0 < 8; ++d0) S.qr[d0] = load8(nxt.Q + (size_t)(wid * QBLK + r32) * D + d0 * 16 + hi * 8);
    SBAR();
    finishSM(pA0, pA1, alA, l_reg, pa0, pa1, pa2, pa3); SBAR();
    pv_tile<0>(o, vb0, pa0, pa1, pa2, pa3);
    if (even) { MASKT(pB0, pB1, NT - 1); partialSM(pB0, pB1, m_reg, mnB, alB); __syncthreads(); RESC(alB);
        finishSM(pB0, pB1, alB, l_reg, pa0, pa1, pa2, pa3); SBAR(); pv_tile<1>(o, vb0, pa0, pa1, pa2, pa3); }
    SBAR(); SEAM_K0();
    if (hi == 0) li_l[r32] = l_reg; asm volatile("s_waitcnt lgkmcnt(0)" ::: "memory");
    float rli[16];
#pragma unroll
    for (int r = 0; r < 16; ++r) rli[r] = __builtin_amdgcn_rcpf(li_l[crow(r, hi)]);
    int lo_ = 4 * hi * LDO + r32; asm volatile("" : "+v"(lo_));
#pragma unroll
    for (int r = 0; r < 16; ++r) { bf16* rowp = cur.O + (size_t)(wid * QBLK + (r & 3) + 8 * (r >> 2)) * LDO;
#pragma unroll
        for (int d0 = 0; d0 < 4; ++d0) { const float v = o[d0][r] * rli[r];
            const float vn = __shfl_xor(v, 1);
            if ((r32 & 1) == 0) *(unsigned*)(rowp + lo_ + d0 * 32) = cvtpk(v, vn); } }
    __syncthreads();
#undef RESC
#undef KBASE
#undef MASKT
#undef SEAM_K0
#undef HALF_STEP
}
#undef ROW
#undef VMW
#undef VMWN
#undef SLOAD_H
#undef SWRITE_HK
#undef SWRITE_HV
#undef SWRITE_H

__device__ __forceinline__ void build_cb(const float* lf, int n, LAS float* cbt, LAS float* scan, int tid_in) {
    int tid = tid_in; asm volatile("" : "+v"(tid));
    const int lane = tid & 63, wid = tid >> 6, i0 = tid * 16;
    f32x4 v[4]; float tot = 0.f;
    if (i0 < n) {
#pragma unroll
        for (int j = 0; j < 4; ++j) v[j] = *(const f32x4*)(lf + i0 + 4 * j);
    } else {
#pragma unroll
        for (int j = 0; j < 4; ++j) v[j] = (f32x4){0.f, 0.f, 0.f, 0.f};
    }
#pragma unroll
    for (int j = 0; j < 4; ++j) { v[j][0] += tot; v[j][1] += v[j][0]; v[j][2] += v[j][1]; v[j][3] += v[j][2]; tot = v[j][3]; }
    float inc = tot;
#pragma unroll
    for (int o = 1; o < 64; o <<= 1) { const float t = __shfl_up(inc, o); if (lane >= o) inc += t; }
    if (lane == 63) scan[wid] = inc;
    __syncthreads();
    float base = inc - tot;
    for (int w = 0; w < wid; ++w) base += scan[w];
    if (i0 < n) {
#pragma unroll
        for (int j = 0; j < 4; ++j) { f32x4 o4; o4[0] = -(v[j][0] + base) * LOG2E; o4[1] = -(v[j][1] + base) * LOG2E; o4[2] = -(v[j][2] + base) * LOG2E; o4[3] = -(v[j][3] + base) * LOG2E;
            *(LAS f32x4*)(cbt + i0 + 4 * j) = o4; }
    }
    __syncthreads();
}
#undef SBAR
}

#define XB_TMO      128
#define XB_XCNT(j)  (256  + 64 * (j))
#define XB_XSUB(j)  (1280 + 64 * (j))
#define XB_XGEN(j)  (2304 + 64 * (j))
#define XB_TOP      3328
#define XB_TOPGEN   3392
#define XCD_BAR_WORDS 3456
#define XB_SPIN_CAP (1u << 18)

__device__ __forceinline__ unsigned xb_ld(unsigned* p)              { return __hip_atomic_load(p, __ATOMIC_RELAXED, __HIP_MEMORY_SCOPE_AGENT); }
__device__ __forceinline__ unsigned xb_add(unsigned* p, unsigned v) { return __hip_atomic_fetch_add(p, v, __ATOMIC_RELAXED, __HIP_MEMORY_SCOPE_AGENT); }
__device__ __forceinline__ unsigned xb_xcc_id() { return (unsigned)__builtin_amdgcn_s_getreg((3 << 11) | 20) & 0xFu; }
#define XB_SPIN(cond, bar) do { unsigned _sp = 0; while (cond) { __builtin_amdgcn_s_sleep(1); \
    if ((++_sp & 255u) == 0u) { if (xb_ld(&(bar)[XB_TMO])) break; if (_sp > XB_SPIN_CAP) { atomicAdd(&(bar)[XB_TMO], 1u); break; } } } } while (0)

struct XcdBarrier {
    unsigned* bar; unsigned x;
    volatile LAS unsigned* st;
};

__device__ __forceinline__ XcdBarrier xcd_barrier_post(unsigned* bar, volatile LAS unsigned* st) {
    XcdBarrier b; b.bar = bar; b.x = xb_xcc_id(); b.st = st;
    if (threadIdx.x == 0) (void)xb_add(&bar[XB_XCNT(b.x)], 1u);
    return b;
}
__device__ __forceinline__ void xcd_barrier_complete(unsigned* bar, unsigned x, unsigned& nloc, unsigned& nx) {
    const unsigned G = gridDim.x * gridDim.y * gridDim.z;
    unsigned sum, cnt, mine, sp = 0u;
    for (;;) {
        sum = 0u; cnt = 0u; mine = 0u;
#pragma unroll
        for (unsigned j = 0; j < 16; ++j) { const unsigned c = xb_ld(&bar[XB_XCNT(j)]); sum += c; cnt += (c > 0u) ? 1u : 0u; mine = (j == x) ? c : mine; }
        if (sum == G) break;
        __builtin_amdgcn_s_sleep(1);
        if ((++sp & 255u) == 0u) { if (xb_ld(&bar[XB_TMO])) break; if (sp > XB_SPIN_CAP) { atomicAdd(&bar[XB_TMO], 1u); break; } }
    }
    nloc = mine > 0u ? mine : 1u; nx = cnt > 0u ? cnt : 1u;
}

__device__ __forceinline__ void xcd_barrier(const XcdBarrier& b) {
    asm volatile("s_waitcnt vmcnt(0)" ::: "memory");
    __syncthreads();
    if (threadIdx.x == 0) {
        unsigned* bar = b.bar;
        __builtin_amdgcn_s_waitcnt(0);
        unsigned nloc = b.st[0], nx = b.st[1];
        if (nloc == 0u) { xcd_barrier_complete(bar, b.x, nloc, nx); b.st[0] = nloc; b.st[1] = nx; }
        const unsigned old = xb_add(&bar[XB_XSUB(b.x)], 1u);
        const unsigned gen = old / nloc;
        if (old + 1u == (gen + 1u) * nloc) {
            __builtin_amdgcn_fence(__ATOMIC_RELEASE, "agent");
            asm volatile("s_waitcnt vmcnt(0)" ::: "memory");
            const unsigned og = xb_add(&bar[XB_TOP], 1u);
            const unsigned tg = og / nx;
            if (og + 1u == (tg + 1u) * nx) xb_add(&bar[XB_TOPGEN], 1u);
            else XB_SPIN(xb_ld(&bar[XB_TOPGEN]) == tg, bar);
            __builtin_amdgcn_fence(__ATOMIC_ACQUIRE, "agent");
            xb_add(&bar[XB_XGEN(b.x)], 1u);
            asm volatile("s_waitcnt vmcnt(0)" ::: "memory");
        } else {
            XB_SPIN(xb_ld(&bar[XB_XGEN(b.x)]) == gen, bar);
            __builtin_amdgcn_fence(__ATOMIC_ACQUIRE, "agent");
            asm volatile("s_waitcnt vmcnt(0)" ::: "memory");
        }
    }
    __syncthreads();
}

struct Args { const float* in[18]; float* out; unsigned char* ws; int ph_lo, ph_hi; };

__constant__ float c_invfreq[16] = {1.000000000e+00f, 4.403665960e-01f, 1.939227432e-01f, 8.539710194e-02f, 3.760603070e-02f, 1.656043902e-02f, 7.292664610e-03f, 3.211445874e-03f,
                                    1.414213562e-03f, 6.227723788e-04f, 2.742481884e-04f, 1.207697351e-04f, 5.318296098e-05f, 2.341999971e-05f, 1.031338616e-05f, 4.541670478e-06f};

__device__ __forceinline__ int rowmap(int mode, int n, int row_off) {
    if (mode == 0) return n + row_off;
    if (mode == 1) return (n >> 7) * 256 + (n & 127);
    if (mode == 2) return (n >> 7) * 256 + 128 + (n & 127);
    if (n < 6144) { const int seg = n >> 10, d = n & 127; if (seg < 2 && d < 32) { const int dn = d < 16 ? 2 * d : 2 * (d - 16) + 1; return n - d + dn; } return n; }
    if (n < 6152) return 10240 + (n - 6144);
    if (n < 8200) return 6144 + (n - 6152);
    return 8192 + (n - 8200);
}
struct CvtDesc { const float* W; int K, N; bf16_t* WT; int ldk, kofs, mode; const float* gain; int item; };
__device__ __forceinline__ void cvt_load(const CvtDesc& d, f32x4 (&v)[8], int lane) {
    const int nblk = (d.N + 31) / 32, kb = d.item / nblk, nb = d.item - kb * nblk, k0 = 64 * kb, n0 = 32 * nb;
    const int nn = n0 + 4 * (lane & 7); const bool ok = nn < d.N;
    const float* p = d.W + (size_t)(k0 + (lane >> 3)) * d.N + nn;
#pragma unroll
    for (int i = 0; i < 8; ++i) v[i] = ok ? *(const f32x4*)(p + (size_t)(8 * i) * d.N) : (f32x4){0.f, 0.f, 0.f, 0.f};
}
__device__ __forceinline__ void cvt_store(const CvtDesc& d, const f32x4 (&v)[8], LAS float* scr, int lane) {
    const int nblk = (d.N + 31) / 32, kb = d.item / nblk, nb = d.item - kb * nblk, k0 = 64 * kb, n0 = 32 * nb;
#pragma unroll
    for (int i = 0; i < 8; ++i) { LAS float* q = scr + (8 * i + (lane >> 3)) * 33 + 4 * (lane & 7); q[0] = v[i][0]; q[1] = v[i][1]; q[2] = v[i][2]; q[3] = v[i][3]; }
    asm volatile("s_waitcnt lgkmcnt(0)" ::: "memory");
    const int c = lane & 7;
    f32x4 g0 = {1.f, 1.f, 1.f, 1.f}, g1 = {1.f, 1.f, 1.f, 1.f};
    if (d.gain) { g0 = *(const f32x4*)(d.gain + k0 + 8 * c); g1 = *(const f32x4*)(d.gain + k0 + 8 * c + 4); }
#pragma unroll
    for (int j = 0; j < 4; ++j) { const int n = (lane >> 3) + 8 * j; const LAS float* s = scr + (8 * c) * 33 + n;
        u32x4 o; o.x = cvt_pk_bf16(s[0 * 33] * g0[0], s[1 * 33] * g0[1]); o.y = cvt_pk_bf16(s[2 * 33] * g0[2], s[3 * 33] * g0[3]);
        o.z = cvt_pk_bf16(s[4 * 33] * g1[0], s[5 * 33] * g1[1]); o.w = cvt_pk_bf16(s[6 * 33] * g1[2], s[7 * 33] * g1[3]);
        if (n0 + n < d.N) *(u32x4*)(d.WT + (size_t)rowmap(d.mode, n0 + n, 0) * d.ldk + d.kofs + k0 + 8 * c) = o; }
    asm volatile("s_waitcnt lgkmcnt(0)" ::: "memory");
}
struct CvtTab { const float* in[18]; bf16_t *Wgu, *Wd, *Win, *Wp, *Wout; };
constexpr int CI_G = (DM / 64) * (FF / 32), CI_D = (FF / 64) * (DM / 32), CI_IN = (DM / 64) * ((INC + 31) / 32), CI_P = (1024 / 64) * (DM / 32), CI_O = (DM / 64) * (DM / 32);
constexpr int CVT_N0 = 2 * CI_G + CI_D + CI_IN + 2 * CI_P + CI_O;
constexpr int CVT_N1 = 2 * CI_G + CI_D;
__device__ __forceinline__ CvtDesc cvt_decode(const CvtTab& t, int list, int it) {
    CvtDesc d; int r = it; const int fb = list == 0 ? 2 : 14; const float* gn = t.in[list == 0 ? 1 : 13];
    if (r < CI_G) { d = CvtDesc{t.in[fb], DM, FF, t.Wgu, DM, 0, 1, gn, r}; return d; } r -= CI_G;
    if (r < CI_G) { d = CvtDesc{t.in[fb + 1], DM, FF, t.Wgu, DM, 0, 2, gn, r}; return d; } r -= CI_G;
    if (r < CI_D) { d = CvtDesc{t.in[fb + 2], FF, DM, t.Wd, FF, 0, 0, nullptr, r}; return d; } r -= CI_D;
    if (r < CI_IN) { d = CvtDesc{t.in[6], DM, INC, t.Win, DM, 0, 3, t.in[5], r}; return d; } r -= CI_IN;
    if (r < CI_P) { d = CvtDesc{t.in[10], 1024, DM, t.Wp, DM, 0, 0, nullptr, r}; return d; } r -= CI_P;
    if (r < CI_P) { d = CvtDesc{t.in[11], 1024, DM, t.Wp, DM, 1024, 0, nullptr, r}; return d; } r -= CI_P;
    d = CvtDesc{t.in[12], DM, DM, t.Wout, DM, 0, 0, nullptr, r}; return d;
}
__device__ __forceinline__ void convert_list(const CvtTab& t, int list, int nitems, LAS float* scr, int gw, int NGW, int lane) {
    f32x4 va[8], vb[8], vc[8], vd[8];
    CvtDesc da, db, dc, dd;
    int ia = gw, ib = gw + NGW, ic = gw + 2 * NGW, id = gw + 3 * NGW;
    if (ia < nitems) { da = cvt_decode(t, list, ia); cvt_load(da, va, lane); }
    if (ib < nitems) { db = cvt_decode(t, list, ib); cvt_load(db, vb, lane); }
    if (ic < nitems) { dc = cvt_decode(t, list, ic); cvt_load(dc, vc, lane); }
    while (ia < nitems) {
        if (id < nitems) { dd = cvt_decode(t, list, id); cvt_load(dd, vd, lane); }
        cvt_store(da, va, scr, lane);
        ia = id + NGW;
        if (ia < nitems) { da = cvt_decode(t, list, ia); cvt_load(da, va, lane); }
        if (ib < nitems) cvt_store(db, vb, scr, lane);
        ib = ia + NGW;
        if (ib < nitems) { db = cvt_decode(t, list, ib); cvt_load(db, vb, lane); }
        if (ic < nitems) cvt_store(dc, vc, scr, lane);
        ic = ib + NGW;
        if (ic < nitems) { dc = cvt_decode(t, list, ic); cvt_load(dc, vc, lane); }
        if (id < nitems) cvt_store(dd, vd, scr, lane);
        id = ic + NGW;
    }
}

#ifndef MK_LAUNCHES
#define MK_LAUNCHES 1
#endif
constexpr int LDS_BYTES = 147456;

__global__ void __launch_bounds__(512, 2) fwd_megakernel(Args a) {
    extern __shared__ __attribute__((aligned(16))) unsigned char lds_raw[];
#if MK_LAUNCHES == 1
    cg::grid_group grid = cg::this_grid();
#endif
    LAS unsigned char* lds = (LAS unsigned char*)lds_raw;

#if MK_LAUNCHES == 1
    { volatile LAS unsigned* st0 = (volatile LAS unsigned*)(lds + LDS_BYTES - 64); if (threadIdx.x < 16) st0[threadIdx.x] = 0u; }
    __syncthreads();
    const XcdBarrier xbar = xcd_barrier_post((unsigned*)(a.ws + WS_BAR), (volatile LAS unsigned*)(lds + LDS_BYTES - 64));
#define GSYNC() xcd_barrier(xbar)
#define IN(k) true
    grid.sync();
#else
#define GSYNC() do { } while (0)
#define IN(k) (a.ph_lo == (k))
#endif
#define PHASE_IDS int tid_ = threadIdx.x; asm volatile("" : "+v"(tid_)); const int tid = tid_, lane = tid & 63, wave = __builtin_amdgcn_readfirstlane(tid >> 6); \
    const int gw = vcu * 8 + wave, NGW = G * 8, gt = vcu * 512 + tid, NGT = G * 512; LAS float* scr = (LAS float*)(lds + wave * 16384); (void)gw; (void)NGW; (void)gt; (void)NGT; (void)scr; (void)lane;
    const int G = gridDim.x, bx = blockIdx.x;
    const int vcu = (G % 8 == 0) ? (bx % 8) * (G / 8) + bx / 8 : bx;
    unsigned char* ws = a.ws;
    float* ssq0 = (float*)(ws + WS_SSQ); float* ssq1 = ssq0 + T; float* ssq2 = ssq1 + T; float* ssq3 = ssq2 + T;
    float* rope = (float*)(ws + WS_ROPE); float* logf = (float*)(ws + WS_LOGF);
    bf16_t* Wgu = (bf16_t*)(ws + WS_WGU); bf16_t* Wd = (bf16_t*)(ws + WS_WD); bf16_t* Win = (bf16_t*)(ws + WS_WIN);
    bf16_t* Wp = (bf16_t*)(ws + WS_WP); bf16_t* Wout = (bf16_t*)(ws + WS_WOUT);
    bf16_t* xb = (bf16_t*)(ws + WS_XB); bf16_t* act = (bf16_t*)(ws + WS_BIG); bf16_t* qkv = (bf16_t*)(ws + WS_BIG); bf16_t* merged = (bf16_t*)(ws + WS_BIG);
    bf16_t* gates = (bf16_t*)(ws + WS_GATES);
    const float* x = a.in[0]; float* out = a.out;

    if (IN(0))
    {
        PHASE_IDS
#ifndef REP0
#define REP0 1
#endif
        for (int rep0 = 0; rep0 < REP0; ++rep0) {
        { CvtTab ct; for (int i = 0; i < 18; ++i) ct.in[i] = a.in[i]; ct.Wgu = Wgu; ct.Wd = Wd; ct.Win = Win; ct.Wp = Wp; ct.Wout = Wout;
          convert_list(ct, 0, CVT_N0, scr, gw, NGW, lane); }
#ifdef DIAG_POISON
        { const u32x4 pz = {0xAAAAAAAAu, 0xAAAAAAAAu, 0xAAAAAAAAu, 0xAAAAAAAAu};
          for (size_t i = gt; i < (WS_END - WS_BIG) / 16; i += NGT) *(u32x4*)(ws + WS_BIG + i * 16) = pz;
          for (size_t i = gt; i < (512 * 1024) / 16; i += NGT) *(u32x4*)(ws + WS_LOGF + i * 16) = pz;
          for (size_t i = gt; i < ((size_t)T * DM * 4) / 16; i += NGT) *(u32x4*)((unsigned char*)out + i * 16) = pz; }
#endif
        for (int i = gt; i < (NIN - INC) * DM / 8; i += NGT) *(u32x4*)(Win + (size_t)INC * DM + (size_t)i * 8) = (u32x4){0u, 0u, 0u, 0u};
        for (int i = gt; i < 3 * T; i += NGT) ssq1[i] = 0.f;
        for (int i = gt; i < SEQ * 16; i += NGT) { const int pos = i >> 4, f = i & 15; const float ang = (float)pos * c_invfreq[f];
            double rev = (double)ang * 0.15915494309189535; rev -= __builtin_rint(rev); const float fr = (float)rev;
            rope[2 * i] = __builtin_amdgcn_cosf(fr); rope[2 * i + 1] = __builtin_amdgcn_sinf(fr); }
        { f32x4 xc[8], xn[8];
          if (gw < T) {
#pragma unroll
              for (int j = 0; j < 8; ++j) xc[j] = ((const f32x4*)(x + (size_t)gw * DM) + lane)[64 * j]; }
          for (int m = gw; m < T; m += NGW) { float s = 0.f; const int mn_ = m + NGW < T ? m + NGW : m;
#pragma unroll
            for (int j = 0; j < 8; ++j) xn[j] = ((const f32x4*)(x + (size_t)mn_ * DM) + lane)[64 * j];
            u32x2* o8 = (u32x2*)(xb + (size_t)m * DM) + lane;
#pragma unroll
            for (int j = 0; j < 8; ++j) { const f32x4 v = xc[j]; s += (v[0] * v[0] + v[1] * v[1]) + (v[2] * v[2] + v[3] * v[3]);
                u32x2 w; w.x = cvt_pk_bf16(v[0], v[1]); w.y = cvt_pk_bf16(v[2], v[3]); o8[64 * j] = w; }
            s = wave_sum(s); if (lane == 0) ssq0[m] = s;
#pragma unroll
            for (int j = 0; j < 8; ++j) xc[j] = xn[j]; } }
        asm volatile("" ::: "memory"); }
    }
    GSYNC();
    if (IN(1))
    { pg8::Gemm g{xb, Wgu, DM, DM, DM}; pg8::StaticOrder S; S.init(T, NGU, G, bx); pg8::EpiSwiGLU E{act, ssq0}; pg8::gemm_phase(lds, g, S, E); }
    GSYNC();
    if (IN(2))
    { pg8::Gemm g{act, Wd, FF, FF, FF}; pg8::StaticOrder S; S.init(T, DM, G, bx); pg8::EpiResid E{x, out, xb, ssq1, 0.5f}; pg8::gemm_phase(lds, g, S, E); }
    GSYNC();
    if (IN(3))
    { pg8::Gemm g{xb, Win, DM, DM, DM}; pg8::StaticOrder S; S.init(T, 10240, G, bx); pg8::EpiWin E{qkv, gates, logf, ssq1, rope, a.in[7], a.in[8], a.in[9]}; pg8::gemm_phase(lds, g, S, E); }
    if (IN(3))
    {
        PHASE_IDS
        const bf16_t* Wf = Win + (size_t)10240 * DM; const float* b_forget = a.in[7];
        for (int m = gw; m < T; m += NGW) {
            const u32x4* xr = (const u32x4*)(xb + (size_t)m * DM) + lane; u32x4 xv[4];
#pragma unroll
            for (int j = 0; j < 4; ++j) xv[j] = xr[64 * j];
            float accf[8];
#pragma unroll
            for (int h = 0; h < 8; ++h) { const u32x4* wr_ = (const u32x4*)(Wf + (size_t)h * DM) + lane; float sacc = 0.f;
#pragma unroll
                for (int j = 0; j < 4; ++j) { const u32x4 wv = wr_[64 * j];
                    sacc += bf_lo(xv[j].x) * bf_lo(wv.x) + bf_hi(xv[j].x) * bf_hi(wv.x) + bf_lo(xv[j].y) * bf_lo(wv.y) + bf_hi(xv[j].y) * bf_hi(wv.y)
                          + bf_lo(xv[j].z) * bf_lo(wv.z) + bf_hi(xv[j].z) * bf_hi(wv.z) + bf_lo(xv[j].w) * bf_lo(wv.w) + bf_hi(xv[j].w) * bf_hi(wv.w); }
                accf[h] = wave_sum(sacc); }
            if (lane < 8) { float v = accf[0];
#pragma unroll
                for (int h = 1; h < 8; ++h) v = (lane == h) ? accf[h] : v;
                const float z = v * pg8::rstd_of(ssq1, m) + b_forget[lane];
                const float ls = fminf(z, 0.f) - __logf(1.f + __expf(-fabsf(z)));
                logf[(size_t)((m >> 13) * NH + lane) * SEQ + (m & (SEQ - 1))] = ls; }
        }
    }
    GSYNC();
    if (IN(4))
    {
        using namespace att;
        PHASE_IDS
        char* al = (char*)lds_raw;
        LAS float* cbt = (LAS float*)(lds + LDS_CB); LAS float* dtab = (LAS float*)(lds + LDS_DT); LAS float* scan = (LAS float*)(lds + LDS_SCAN);
        for (int i = tid; i < DT_N; i += 512) { const int dl = i - DT_OFF; float v = -__builtin_inff();
            if (dl >= 0 && dl <= 2048) { const int mlt = (dl <= 128 ? 1 : 0) + (((dl & 3) == 0 && dl <= 512) ? 1 : 0) + (((dl & 15) == 0) ? 1 : 0);
                v = mlt == 0 ? -__builtin_inff() : (mlt == 1 ? 0.f : (mlt == 2 ? 1.f : 1.5849625007211562f)); }
            dtab[i] = v; }
        __syncthreads();
        constexpr int NFOX = 256, NDIL = 256, TOTAL = NFOX + NDIL;
        const bf16* qkvb = (const bf16*)qkv; bf16* ycat = (bf16*)xb;
        struct Item { int mode, bh, qb0, qb1; };
        auto decode = [&](int L) { Item it; const unsigned long long FA = 0x5432DB910AFEC876ull;
            if (L < NFOX) { it.mode = 0; it.bh = L >> 4; const int sl = L & 15; it.qb0 = (int)((FA >> (4 * sl)) & 15);
                const int sums = sl < 8 ? 37 - sl : (sl < 12 ? 29 : 28); it.qb1 = sums - it.qb0; }
            else { const int l2 = L - NFOX; it.mode = 1; it.bh = l2 >> 4; const int sl = l2 & 15; if (sl < 8) { it.qb0 = sl; it.qb1 = 8 + sl; } else { it.qb0 = 2 * sl; it.qb1 = 2 * sl + 1; } }
            return it; };
        auto mkref = [&](const Item& it, int pass) { const int qb = pass ? it.qb1 : it.qb0; BlockRef r; const size_t seg = (size_t)T * 1024; const int sb = it.mode == 0 ? 3 : 0;
            const size_t hb = (size_t)it.bh * SEQ * HD;
            r.Q = qkvb + (sb + 0) * seg + hb + (size_t)qb * QB * HD; r.K = qkvb + (sb + 1) * seg + hb; r.V = qkvb + (sb + 2) * seg + hb;
            r.O = ycat + ((size_t)(it.bh >> 3) * SEQ + (size_t)qb * QB) * LDO + (it.mode == 0 ? 1024 : 0) + (it.bh & 7) * HD; r.P0 = qb * QB; r.W = it.mode == 0 ? (1 << 30) : 2049;
            return r; };
#define ATT_STREAM(MODE_, LBEG, LEND) do { int L = (LBEG) + vcu; if (L < (LEND)) { \
            Item it = decode(L); int pass = 0; BlockRef cur = mkref(it, 0); Seam S; \
            attn_prime<MODE_>(cur, al, S); \
            for (;;) { \
                const bool more_pass = pass == 0 && it.qb1 != it.qb0, more_item = L + G < (LEND), last = !more_pass && !more_item; \
                Item itn = it; int passn = pass + 1, Ln = L; \
                if (!more_pass) { passn = 0; Ln = more_item ? L + G : L; itn = decode(Ln); } \
                const BlockRef nxt = last ? cur : mkref(itn, passn); \
                if (MODE_ == 0 && pass == 0) { const int mq = it.qb0 > it.qb1 ? it.qb0 : it.qb1; build_cb(logf + (size_t)it.bh * SEQ, (mq + 1) * QB, cbt, scan, tid); } \
                attn_block<MODE_>(cur, nxt, al, cbt, dtab, S); \
                if (last) break; \
                cur = nxt; it = itn; pass = passn; L = Ln; \
            } } } while (0)
#ifndef REP4
#define REP4 1
#endif
        for (int rep4 = 0; rep4 < REP4; ++rep4) {
        ATT_STREAM(0, 0, NFOX);
        __syncthreads();
        ATT_STREAM(1, NFOX, TOTAL);
        __syncthreads(); }
#undef ATT_STREAM
    }
    GSYNC();
    if (IN(5))
    {
        PHASE_IDS
        { CvtTab ct; for (int i = 0; i < 18; ++i) ct.in[i] = a.in[i]; ct.Wgu = Wgu; ct.Wd = Wd; ct.Win = Win; ct.Wp = Wp; ct.Wout = Wout;
          convert_list(ct, 1, CVT_N1, scr, gw, NGW, lane); }
        __syncthreads();
        pg8::Gemm g{xb, Wp, 1024, DM, DM}; pg8::StaticOrder S; S.init(T, DM, G, bx, 2); pg8::EpiProj E{gates, merged}; pg8::gemm_phase(lds, g, S, E);
    }
    GSYNC();
    if (IN(6))
    { pg8::Gemm g{merged, Wout, DM, DM, DM}; pg8::StaticOrder S; S.init(T, DM, G, bx); pg8::EpiResid E{out, out, xb, ssq2, 1.0f}; pg8::gemm_phase(lds, g, S, E); }
    GSYNC();
    if (IN(7))
    { pg8::Gemm g{xb, Wgu, DM, DM, DM}; pg8::StaticOrder S; S.init(T, NGU, G, bx); pg8::EpiSwiGLU E{act, ssq2}; pg8::gemm_phase(lds, g, S, E); }
    GSYNC();
    if (IN(8))
    { pg8::Gemm g{act, Wd, FF, FF, FF}; pg8::StaticOrder S; S.init(T, DM, G, bx); pg8::EpiResid E{out, out, nullptr, ssq3, 0.5f}; pg8::gemm_phase(lds, g, S, E); }
    GSYNC();
    if (IN(9))
    {
        PHASE_IDS
        const float* fn = a.in[17];
        for (int m = gw; m < T; m += NGW) { f32x4* xr = (f32x4*)(out + (size_t)m * DM) + lane; const float rs = rsqrtf(ssq3[m] * (1.f / (float)DM) + EPS);
#pragma unroll
            for (int j = 0; j < 8; ++j) { const f32x4 gg = *((const f32x4*)fn + lane + 64 * j); f32x4 v = xr[64 * j]; v = v * rs * gg; xr[64 * j] = v; } }
    }
}

extern "C" void kernel_launch(void* const* d_in, const int* in_sizes, int n_in, void* d_out, int out_size, void* d_ws, size_t ws_size, hipStream_t stream) {
    static int grid = 0;
    if (grid == 0) {
        if (n_in != 18 || out_size != T * DM || ws_size < WS_END) { fprintf(stderr, "kernel_launch: unexpected shapes n_in %d out %d ws %zu\n", n_in, out_size, ws_size); grid = -1; return; }
        int dev = 0, cus = 0, per_cu = 0;
        (void)hipGetDevice(&dev); (void)hipDeviceGetAttribute(&cus, hipDeviceAttributeMultiprocessorCount, dev);
        if (hipFuncSetAttribute((const void*)fwd_megakernel, hipFuncAttributeMaxDynamicSharedMemorySize, LDS_BYTES) != hipSuccess) { fprintf(stderr, "hipFuncSetAttribute failed\n"); grid = -1; return; }
        if (hipOccupancyMaxActiveBlocksPerMultiprocessor(&per_cu, (const void*)fwd_megakernel, 512, LDS_BYTES) != hipSuccess || per_cu < 1) { fprintf(stderr, "occupancy query: %d\n", per_cu); per_cu = 1; }
        (void)hipGetLastError();
        grid = cus * per_cu;
        fprintf(stderr, "kernel_launch: grid %d (cus %d x %d)\n", grid, cus, per_cu);
    }
    if (grid < 0) return;
    (void)hipMemsetAsync((char*)d_ws + WS_BAR, 0, XCD_BAR_WORDS * 4, stream);
    Args a{};
    for (int i = 0; i < 18; ++i) a.in[i] = (const float*)d_in[i];
    a.out = (float*)d_out; a.ws = (unsigned char*)d_ws;
#if MK_LAUNCHES == 1
    a.ph_lo = 0; a.ph_hi = 10;
    void* args[] = {&a};
    hipError_t e = hipLaunchCooperativeKernel((const void*)fwd_megakernel, dim3(grid), dim3(512), args, LDS_BYTES, stream);
    if (e != hipSuccess) fprintf(stderr, "cooperative launch failed: %s (grid %d)\n", hipGetErrorString(e), grid);
#else
    for (int k = 0; k < 10; ++k) { a.ph_lo = k; a.ph_hi = k + 1; hipLaunchKernelGGL(fwd_megakernel, dim3(grid), dim3(512), LDS_BYTES, stream, a); }
#endif
}
```

```cpp
#include <hip/hip_runtime.h>
#include <hip/hip_bf16.h>
#include <hip/hip_cooperative_groups.h>
#include <cstdio>
#include <cstdint>
namespace cg = cooperative_groups;

#define LAS __attribute__((address_space(3)))
typedef unsigned short bf16_t;
typedef short bf16x8 __attribute__((ext_vector_type(8)));
typedef short s16x4 __attribute__((ext_vector_type(4)));
typedef float f32x4 __attribute__((ext_vector_type(4)));
typedef float f32x16 __attribute__((ext_vector_type(16)));
typedef unsigned u32x4 __attribute__((ext_vector_type(4)));
typedef unsigned u32x2 __attribute__((ext_vector_type(2)));

constexpr int T = 16384, SEQ = 8192, DM = 2048, FF = 5632, NH = 8, HD = 128;
constexpr int NGU = 2 * FF;
constexpr int NIN = 10496;
constexpr int INC = 10248;
constexpr float EPS = 1e-6f;
constexpr float LOG2E = 1.4426950408889634f;
constexpr float QSCALE = 0.08838834764831845f * LOG2E;

constexpr size_t MiB = 1u << 20;
constexpr size_t WS_SSQ = 0;
constexpr size_t WS_BAR = 512 * 1024;
constexpr size_t WS_ROPE = 1 * MiB;
constexpr size_t WS_LOGF = 2 * MiB;
constexpr size_t WS_WGU = 3 * MiB;
constexpr size_t WS_WD = 47 * MiB;
constexpr size_t WS_WIN = 69 * MiB;
constexpr size_t WS_WP = 110 * MiB;
constexpr size_t WS_WOUT = 118 * MiB;
constexpr size_t WS_XB = 126 * MiB;
constexpr size_t WS_BIG = 190 * MiB;
constexpr size_t WS_GATES = 382 * MiB;
constexpr size_t WS_END = 510 * MiB;

typedef float f32x2_t __attribute__((ext_vector_type(2))); typedef __bf16 bf16x2_t __attribute__((ext_vector_type(2)));
__device__ __forceinline__ unsigned cvt_pk_bf16(float lo, float hi) { f32x2_t v = {lo, hi}; bf16x2_t b = __builtin_convertvector(v, bf16x2_t); return __builtin_bit_cast(unsigned, b); }
__device__ __forceinline__ float bf_lo(unsigned w) { return __uint_as_float(w << 16); }
__device__ __forceinline__ float bf_hi(unsigned w) { return __uint_as_float(w & 0xffff0000u); }
__device__ __forceinline__ float wave_sum(float v) {
#pragma unroll
    for (int o = 1; o < 64; o <<= 1) v += __shfl_xor(v, o);
    return v;
}

namespace pg8 {
constexpr int BM = 256, BK = 64, HALF = 128, HTB = HALF * BK * 2, STAGE_BYTES = 8 * HTB, NXCD = 8, WGM = 8;
__host__ __device__ __forceinline__ int lds_byte(int r, int c) { const int st = (r >> 4) * 2 + (c >> 5), rr = r & 15, cc = c & 31, ob = rr * 64 + cc * 2; return st * 1024 + (ob ^ (((ob >> 9) & 1) << 5)); }
__host__ __device__ __forceinline__ void stage_rc(int b, int& R, int& C) { const int st = b / 1024, sb = b % 1024, swz = sb ^ (((sb >> 9) & 1) << 5); R = (st >> 1) * 16 + swz / 64; C = (st & 1) * 32 + (swz % 64) / 2; }
__host__ __device__ __forceinline__ int perm32(int rho) { const int n = rho >> 4, i = rho & 15; return 8 * (i >> 2) + 4 * n + (i & 3); }

struct Unit { int pm, pn, ko, half; };
struct Gemm { const bf16_t* A; const bf16_t* Bt; int K, lda, ldb; };

struct StaticOrder {
    int nM, nN, nwg, G, c, halves;
    __device__ void init(int M, int N, int G_, int c_, int halves_ = 1) { nM = M / BM; nN = N / BM; nwg = nM * nN; G = G_; c = c_; halves = halves_; }
    __device__ bool next(int i, Unit& u) const {
        const int it = i / halves, hf = i - it * halves;
        const long L = (long)it * G + c; if (L >= nwg) return false;
        int wgid = (int)L; { const int q = nwg / NXCD, r = nwg % NXCD, xcd = wgid % NXCD, off = wgid / NXCD; wgid = (xcd < r ? xcd * (q + 1) : r * (q + 1) + (xcd - r) * q) + off; }
        const int nig = WGM * nN, gid = wgid / nig, fm = gid * WGM, gsz = (nM - fm) < WGM ? (nM - fm) : WGM;
        u.pm = fm + ((wgid % nig) % gsz); u.pn = (wgid % nig) / gsz; u.half = hf; u.ko = hf * 1024; return true;
    }
};

template <class Epi, class Sched>
__device__ __forceinline__ void gemm_phase(LAS unsigned char* lds, const Gemm g, const Sched& S, const Epi& E) {
    int tid_ = threadIdx.x; asm volatile("" : "+v"(tid_));
    const int tid = tid_, wid = __builtin_amdgcn_readfirstlane(tid >> 6), lane = tid & 63, wr = wid >> 2, wc = wid & 3, fr = lane & 15, fq = lane >> 4;
    const int nt = g.K / BK;
    unsigned voffA[2], voffB[2];
#pragma unroll
    for (int i = 0; i < 2; ++i) { int R, C; stage_rc(tid * 16 + i * 8192, R, C); const int Rb = (R & ~31) + perm32(R & 31);
        voffA[i] = (unsigned)(R * g.lda + C) * 2u; voffB[i] = (unsigned)(Rb * g.ldb + C) * 2u; }
    const size_t kstep = (size_t)(BK * 2);
    const size_t hstepA = (size_t)HALF * g.lda * 2, hstepB = (size_t)HALF * g.ldb * 2;
    const size_t tstepA = 2 * hstepA, tstepB = 2 * hstepB;
    const unsigned ldsw = (unsigned)wid * 1024u;
    const int aoff = lds_byte(wr * 64 + fr, fq * 8), boff = lds_byte(wc * 32 + fr, fq * 8);
#define PG8_SA(b, h) (((b) * 2 + (h)) * HTB)
#define PG8_SB(b, h) ((4 + (b) * 2 + (h)) * HTB)
#define PG8_STAGE(bufoff, gbase, voff) do { _Pragma("unroll") for (int _i = 0; _i < 2; ++_i) \
        __builtin_amdgcn_global_load_lds((const unsigned*)((const char*)(gbase) + (voff)[_i]), (LAS unsigned*)(lds + (bufoff) + ldsw + _i * 8192), 16, 0, 0); } while (0)
#define PG8_LDA(dst, b, h) do { _Pragma("unroll") for (int m = 0; m < 4; ++m) _Pragma("unroll") for (int k = 0; k < 2; ++k) dst[m][k] = *(const LAS bf16x8*)(lds + PG8_SA(b, h) + aoff + m * 2048 + k * 1024); } while (0)
#define PG8_LDB(dst, b, h) do { _Pragma("unroll") for (int n = 0; n < 2; ++n) _Pragma("unroll") for (int k = 0; k < 2; ++k) dst[n][k] = *(const LAS bf16x8*)(lds + PG8_SB(b, h) + boff + n * 2048 + k * 1024); } while (0)
#define PG8_MMA(ai, bj, At, Bt) do { __builtin_amdgcn_s_setprio(1); _Pragma("unroll") for (int m = 0; m < 4; ++m) _Pragma("unroll") for (int n = 0; n < 2; ++n) _Pragma("unroll") for (int k = 0; k < 2; ++k) \
        acc[ai][bj][m][n] = __builtin_amdgcn_mfma_f32_16x16x32_bf16(Bt[n][k], At[m][k], acc[ai][bj][m][n], 0, 0, 0); __builtin_amdgcn_s_setprio(0); } while (0)
#define PG8_WAIT_V(n) asm volatile("s_waitcnt vmcnt(" #n ")" ::: "memory")
#define PG8_WAIT_L(n) asm volatile("s_waitcnt lgkmcnt(" #n ")" ::: "memory")
#define PG8_BAR __builtin_amdgcn_s_barrier()
#define PG8_SCHED __builtin_amdgcn_sched_barrier(0)
    Unit cur, nxt; int ui = 0;
    if (!S.next(0, cur)) return;
    constexpr int RELAX = (8 + Epi::STORES) > 63 ? 63 : (8 + Epi::STORES);
#define PG8_WAIT_V8F do { if (Epi::STORES > 0 && t == 0) asm volatile("s_waitcnt vmcnt(%0)" :: "i"(RELAX) : "memory"); else asm volatile("s_waitcnt vmcnt(8)" ::: "memory"); } while (0)
    f32x4 acc[2][2][4][2];
#pragma unroll
    for (int a = 0; a < 2; ++a)
#pragma unroll
        for (int b = 0; b < 2; ++b)
#pragma unroll
            for (int m = 0; m < 4; ++m)
#pragma unroll
                for (int n = 0; n < 2; ++n) acc[a][b][m][n] = (f32x4){0.f, 0.f, 0.f, 0.f};
    bf16x8 At[4][2], B0[2][2], B1[2][2];
    const char* cA = (const char*)g.A + (size_t)cur.pm * tstepA + (size_t)cur.ko * 2; const char* cB = (const char*)g.Bt + (size_t)cur.pn * tstepB + (size_t)cur.ko * 2;
    PG8_STAGE(PG8_SB(0, 0), cB, voffB); PG8_STAGE(PG8_SB(0, 1), cB + hstepB, voffB); PG8_STAGE(PG8_SA(0, 0), cA, voffA); PG8_STAGE(PG8_SA(0, 1), cA + hstepA, voffA);
    if (wr == 1) PG8_BAR;
    PG8_WAIT_V(2); PG8_BAR;
    PG8_STAGE(PG8_SB(1, 0), cB + kstep, voffB); PG8_STAGE(PG8_SA(1, 0), cA + kstep, voffA); PG8_STAGE(PG8_SB(1, 1), cB + hstepB + kstep, voffB);
    if (Epi::STORES > 0) { PG8_WAIT_V(0); } else { PG8_WAIT_V(6); } PG8_BAR;
    for (;;) {
        const bool has_next = S.next(ui + 1, nxt);
        const char* nA = has_next ? (const char*)g.A + (size_t)nxt.pm * tstepA + (size_t)nxt.ko * 2 : cA; const char* nB = has_next ? (const char*)g.Bt + (size_t)nxt.pn * tstepB + (size_t)nxt.ko * 2 : cB;
        for (int t = 0; t < nt; t += 2) {
            const bool last = (t == nt - 2);
            const char* a1 = cA + (size_t)(t + 1) * kstep;
            const char* a2 = last ? nA : cA + (size_t)(t + 2) * kstep; const char* b2 = last ? nB : cB + (size_t)(t + 2) * kstep;
            const char* a3 = a2 + kstep; const char* b3 = b2 + kstep;
            PG8_LDB(B0, 0, 0); PG8_LDB(B1, 0, 1); PG8_SCHED; PG8_LDA(At, 0, 0); PG8_STAGE(PG8_SA(1, 1), a1 + hstepA, voffA);
            PG8_WAIT_V8F; PG8_WAIT_L(0); PG8_BAR; PG8_MMA(0, 0, At, B0); PG8_MMA(0, 1, At, B1); PG8_BAR; PG8_SCHED;
            PG8_LDA(At, 0, 1); PG8_STAGE(PG8_SB(0, 0), b2, voffB); PG8_STAGE(PG8_SB(0, 1), b2 + hstepB, voffB); PG8_STAGE(PG8_SA(0, 0), a2, voffA);
            PG8_WAIT_V8F; PG8_WAIT_L(0); PG8_BAR; PG8_MMA(1, 0, At, B0); PG8_MMA(1, 1, At, B1); PG8_BAR; PG8_SCHED;
            PG8_LDB(B0, 1, 0); PG8_LDB(B1, 1, 1); PG8_SCHED; PG8_LDA(At, 1, 0); PG8_STAGE(PG8_SA(0, 1), a2 + hstepA, voffA);
            PG8_WAIT_V(8); PG8_WAIT_L(0); PG8_BAR; PG8_MMA(0, 0, At, B0); PG8_MMA(0, 1, At, B1); PG8_BAR; PG8_SCHED;
            PG8_LDA(At, 1, 1); PG8_STAGE(PG8_SB(1, 0), b3, voffB); PG8_STAGE(PG8_SB(1, 1), b3 + hstepB, voffB); PG8_STAGE(PG8_SA(1, 0), a3, voffA);
            PG8_WAIT_V(8); PG8_WAIT_L(0); PG8_BAR; PG8_MMA(1, 0, At, B0); PG8_MMA(1, 1, At, B1); PG8_BAR; PG8_SCHED;
        }
        if (wr == 0) PG8_BAR;
        E(acc, cur, wr, wc, fr, fq);
        if (!has_next) break;
#pragma unroll
        for (int a = 0; a < 2; ++a)
#pragma unroll
            for (int b = 0; b < 2; ++b)
#pragma unroll
                for (int m = 0; m < 4; ++m)
#pragma unroll
                    for (int n = 0; n < 2; ++n) acc[a][b][m][n] = (f32x4){0.f, 0.f, 0.f, 0.f};
        cur = nxt; cA = nA; cB = nB; ++ui;
        if (wr == 1) PG8_BAR;
    }
    PG8_WAIT_V(0);
    PG8_BAR;
#undef PG8_SA
#undef PG8_SB
#undef PG8_STAGE
#undef PG8_LDA
#undef PG8_LDB
#undef PG8_MMA
#undef PG8_WAIT_V
#undef PG8_WAIT_L
#undef PG8_BAR
#undef PG8_SCHED
}

typedef const f32x4 (&AccRef)[2][2][4][2];

__device__ __forceinline__ float rstd_of(const float* ssq, int r) { return rsqrtf(ssq[r] * (1.f / (float)DM) + EPS); }
__device__ __forceinline__ float silu_mul(float g, float u) { return g * __builtin_amdgcn_rcpf(1.f + __builtin_amdgcn_exp2f(-g * LOG2E)) * u; }
__device__ __forceinline__ float sigmoidf_(float z) { return __builtin_amdgcn_rcpf(1.f + __builtin_amdgcn_exp2f(-z * LOG2E)); }

struct EpiSwiGLU {
    static constexpr int STORES = 8;
    bf16_t* O; const float* ssq;
    __device__ __forceinline__ void operator()(AccRef acc, const Unit& u, int wr, int wc, int fr, int fq) const {
        const int row0 = u.pm * BM + wr * 64 + fr, col = u.pn * HALF + wc * 32 + 8 * fq;
        float rsv[8];
#pragma unroll
        for (int i = 0; i < 8; ++i) rsv[i] = ssq[row0 + (i >> 2) * HALF + (i & 3) * 16];
#pragma unroll
        for (int i = 0; i < 8; ++i) rsv[i] = rsqrtf(rsv[i] * (1.f / (float)DM) + EPS);
#pragma unroll
        for (int ai = 0; ai < 2; ++ai)
#pragma unroll
            for (int m = 0; m < 4; ++m) { const int r = row0 + ai * HALF + m * 16; const float rs = rsv[ai * 4 + m];
                const f32x4 g0 = acc[ai][0][m][0] * rs, g1 = acc[ai][0][m][1] * rs, u0 = acc[ai][1][m][0] * rs, u1 = acc[ai][1][m][1] * rs;
                u32x4 w; w.x = cvt_pk_bf16(silu_mul(g0[0], u0[0]), silu_mul(g0[1], u0[1])); w.y = cvt_pk_bf16(silu_mul(g0[2], u0[2]), silu_mul(g0[3], u0[3]));
                w.z = cvt_pk_bf16(silu_mul(g1[0], u1[0]), silu_mul(g1[1], u1[1])); w.w = cvt_pk_bf16(silu_mul(g1[2], u1[2]), silu_mul(g1[3], u1[3]));
                *(u32x4*)(O + (size_t)r * FF + col) = w; }
    }
};
struct EpiResid {
    static constexpr int STORES = 40;
    const float* resid; float* out; bf16_t* xb; float* ssq; float alpha;
    __device__ __forceinline__ void operator()(AccRef acc, const Unit& u, int wr, int wc, int fr, int fq) const {
        const int row0 = u.pm * BM + wr * 64 + fr, col0 = u.pn * BM + wc * 32 + 8 * fq;
        f32x4 cur[4], nxt[4];
        { const size_t off = (size_t)row0 * DM + col0; cur[0] = *(const f32x4*)(resid + off); cur[1] = *(const f32x4*)(resid + off + 4); cur[2] = *(const f32x4*)(resid + off + HALF); cur[3] = *(const f32x4*)(resid + off + HALF + 4); }
#pragma unroll
        for (int i = 0; i < 8; ++i) { const int ai = i >> 2, m = i & 3; const int r = row0 + ai * HALF + m * 16; float sq = 0.f;
            if (i < 7) { const int rn = row0 + ((i + 1) >> 2) * HALF + ((i + 1) & 3) * 16; const size_t off = (size_t)rn * DM + col0;
                nxt[0] = *(const f32x4*)(resid + off); nxt[1] = *(const f32x4*)(resid + off + 4); nxt[2] = *(const f32x4*)(resid + off + HALF); nxt[3] = *(const f32x4*)(resid + off + HALF + 4); }
            asm volatile("" ::: "memory");
#pragma unroll
            for (int bj = 0; bj < 2; ++bj) { const size_t off = (size_t)r * DM + col0 + bj * HALF;
                const f32x4 o0 = cur[2 * bj] + acc[ai][bj][m][0] * alpha, o1 = cur[2 * bj + 1] + acc[ai][bj][m][1] * alpha;
                *(f32x4*)(out + off) = o0; *(f32x4*)(out + off + 4) = o1;
                sq += (o0[0] * o0[0] + o0[1] * o0[1]) + (o0[2] * o0[2] + o0[3] * o0[3]) + (o1[0] * o1[0] + o1[1] * o1[1]) + (o1[2] * o1[2] + o1[3] * o1[3]);
                if (xb) { u32x4 w; w.x = cvt_pk_bf16(o0[0], o0[1]); w.y = cvt_pk_bf16(o0[2], o0[3]); w.z = cvt_pk_bf16(o1[0], o1[1]); w.w = cvt_pk_bf16(o1[2], o1[3]); *(u32x4*)(xb + off) = w; } }
            sq += __shfl_xor(sq, 16); sq += __shfl_xor(sq, 32);
            if (fq == 0) atomicAdd(ssq + r, sq);
#pragma unroll
            for (int k = 0; k < 4; ++k) cur[k] = nxt[k]; }
    }
};
struct EpiWin {
    static constexpr int STORES = 0;
    bf16_t* qkv; bf16_t* gates; float* logf; const float* ssq; const float* rope; const float* b_forget; const float* b_gd; const float* b_gf;
    __device__ __forceinline__ void operator()(AccRef acc, const Unit& u, int wr, int wc, int fr, int fq) const {
        const int row0 = u.pm * BM + wr * 64 + fr, pn = u.pn;
        float rsv[8];
#pragma unroll
        for (int i = 0; i < 8; ++i) rsv[i] = ssq[row0 + (i >> 2) * HALF + (i & 3) * 16];
#pragma unroll
        for (int i = 0; i < 8; ++i) rsv[i] = rsqrtf(rsv[i] * (1.f / (float)DM) + EPS);
        if (pn < 24) {
            const int which = pn >> 2; const bool rot = (which < 2) && (wc == 0); const float qs = (which == 0 || which == 3) ? QSCALE : 1.f;
            bf16_t* base = qkv + (size_t)which * ((size_t)T * 1024);
            f32x4 cs0 = {1.f, 0.f, 1.f, 0.f}, cs1 = {1.f, 0.f, 1.f, 0.f}, ns0 = cs0, ns1 = cs1;
            if (rot) { const int s0 = row0 & (SEQ - 1); cs0 = *(const f32x4*)(rope + ((size_t)s0 * 16 + 4 * fq) * 2); cs1 = *(const f32x4*)(rope + ((size_t)s0 * 16 + 4 * fq) * 2 + 4); }
#pragma unroll
            for (int i = 0; i < 8; ++i) { const int ai = i >> 2, m = i & 3; const int r = row0 + ai * HALF + m * 16; const float rs = rsv[i] * qs; const int b = r >> 13, sp = r & (SEQ - 1);
                if (rot && i < 7) { const int sn = (row0 + ((i + 1) >> 2) * HALF + ((i + 1) & 3) * 16) & (SEQ - 1);
                    ns0 = *(const f32x4*)(rope + ((size_t)sn * 16 + 4 * fq) * 2); ns1 = *(const f32x4*)(rope + ((size_t)sn * 16 + 4 * fq) * 2 + 4); }
                asm volatile("" ::: "memory");
#pragma unroll
                for (int bj = 0; bj < 2; ++bj) { const int head = 2 * (pn & 3) + bj;
                    f32x4 v0 = acc[ai][bj][m][0] * rs, v1 = acc[ai][bj][m][1] * rs;
                    if (rot) { f32x4 t0, t1;
                        t0[0] = v0[0] * cs0[0] - v0[1] * cs0[1]; t0[1] = v0[1] * cs0[0] + v0[0] * cs0[1]; t0[2] = v0[2] * cs0[2] - v0[3] * cs0[3]; t0[3] = v0[3] * cs0[2] + v0[2] * cs0[3];
                        t1[0] = v1[0] * cs1[0] - v1[1] * cs1[1]; t1[1] = v1[1] * cs1[0] + v1[0] * cs1[1]; t1[2] = v1[2] * cs1[2] - v1[3] * cs1[3]; t1[3] = v1[3] * cs1[2] + v1[2] * cs1[3];
                        v0 = t0; v1 = t1; }
                    u32x4 w; w.x = cvt_pk_bf16(v0[0], v0[1]); w.y = cvt_pk_bf16(v0[2], v0[3]); w.z = cvt_pk_bf16(v1[0], v1[1]); w.w = cvt_pk_bf16(v1[2], v1[3]);
                    *(u32x4*)(base + ((size_t)(b * NH + head) * SEQ + sp) * HD + wc * 32 + 8 * fq) = w; }
                cs0 = ns0; cs1 = ns1; }
        } else {
            const int gi = (pn - 24) >> 3, ct = (pn - 24) & 7; const float* bias = gi ? b_gf : b_gd; bf16_t* gb = gates + (size_t)gi * ((size_t)T * DM);
            const int col0 = ct * BM + wc * 32 + 8 * fq;
            f32x4 bv[2][2];
#pragma unroll
            for (int bj = 0; bj < 2; ++bj) { bv[bj][0] = *(const f32x4*)(bias + col0 + bj * HALF); bv[bj][1] = *(const f32x4*)(bias + col0 + bj * HALF + 4); }
#pragma unroll
            for (int ai = 0; ai < 2; ++ai)
#pragma unroll
                for (int m = 0; m < 4; ++m) { const int r = row0 + ai * HALF + m * 16; const float rs = rsv[ai * 4 + m];
#pragma unroll
                    for (int bj = 0; bj < 2; ++bj) { const f32x4 v0 = acc[ai][bj][m][0] * rs + bv[bj][0], v1 = acc[ai][bj][m][1] * rs + bv[bj][1];
                        u32x4 w; w.x = cvt_pk_bf16(sigmoidf_(v0[0]), sigmoidf_(v0[1])); w.y = cvt_pk_bf16(sigmoidf_(v0[2]), sigmoidf_(v0[3]));
                        w.z = cvt_pk_bf16(sigmoidf_(v1[0]), sigmoidf_(v1[1])); w.w = cvt_pk_bf16(sigmoidf_(v1[2]), sigmoidf_(v1[3]));
                        *(u32x4*)(gb + (size_t)r * DM + col0 + bj * HALF) = w; } }
        }
    }
};
struct EpiProj {
    static constexpr int STORES = 16;
    const bf16_t* gates; bf16_t* merged;
    __device__ __forceinline__ void operator()(AccRef acc, const Unit& u, int wr, int wc, int fr, int fq) const {
        const int row0 = u.pm * BM + wr * 64 + fr, col0 = u.pn * BM + wc * 32 + 8 * fq;
        const bf16_t* gb = gates + (size_t)u.half * ((size_t)T * DM);
        const u32x4 zz = {0u, 0u, 0u, 0u};
        u32x4 cg[2], cp[2] = {zz, zz}, ng[2], np[2] = {zz, zz};
        { const size_t off = (size_t)row0 * DM + col0; cg[0] = *(const u32x4*)(gb + off); cg[1] = *(const u32x4*)(gb + off + HALF);
          if (u.half) { cp[0] = *(const u32x4*)(merged + off); cp[1] = *(const u32x4*)(merged + off + HALF); } }
#pragma unroll
        for (int i = 0; i < 8; ++i) { const int ai = i >> 2, m = i & 3; const int r = row0 + ai * HALF + m * 16;
            if (i < 7) { const int rn = row0 + ((i + 1) >> 2) * HALF + ((i + 1) & 3) * 16; const size_t off = (size_t)rn * DM + col0;
                ng[0] = *(const u32x4*)(gb + off); ng[1] = *(const u32x4*)(gb + off + HALF);
                if (u.half) { np[0] = *(const u32x4*)(merged + off); np[1] = *(const u32x4*)(merged + off + HALF); } }
            asm volatile("" ::: "memory");
#pragma unroll
            for (int bj = 0; bj < 2; ++bj) { const size_t off = (size_t)r * DM + col0 + bj * HALF;
                const u32x4 gv = cg[bj], pv = cp[bj];
                f32x4 v0 = acc[ai][bj][m][0], v1 = acc[ai][bj][m][1];
                v0[0] *= bf_lo(gv.x); v0[1] *= bf_hi(gv.x); v0[2] *= bf_lo(gv.y); v0[3] *= bf_hi(gv.y);
                v1[0] *= bf_lo(gv.z); v1[1] *= bf_hi(gv.z); v1[2] *= bf_lo(gv.w); v1[3] *= bf_hi(gv.w);
                if (u.half) {
                    v0[0] += bf_lo(pv.x); v0[1] += bf_hi(pv.x); v0[2] += bf_lo(pv.y); v0[3] += bf_hi(pv.y);
                    v1[0] += bf_lo(pv.z); v1[1] += bf_hi(pv.z); v1[2] += bf_lo(pv.w); v1[3] += bf_hi(pv.w); }
                u32x4 w; w.x = cvt_pk_bf16(v0[0], v0[1]); w.y = cvt_pk_bf16(v0[2], v0[3]); w.z = cvt_pk_bf16(v1[0], v1[1]); w.w = cvt_pk_bf16(v1[2], v1[3]);
                *(u32x4*)(merged + off) = w; }
            cg[0] = ng[0]; cg[1] = ng[1]; cp[0] = np[0]; cp[1] = np[1]; }
    }
};
}

namespace att {
using bf16 = __hip_bfloat16;
constexpr int D = 128, NW = 8, QBLK = 32, KVBLK = 64, QB = NW * QBLK, LDO = 2048;
constexpr int SHM_V = KVBLK * D * 2, SHM_K = KVBLK * D * 2;
constexpr int LDS_WSF = 2 * SHM_V + 2 * SHM_K;
constexpr int LDS_CB = LDS_WSF + 2048;
constexpr int LDS_DT = LDS_CB + 32768;
constexpr int DT_N = 2624, DT_OFF = 320;
constexpr int LDS_SCAN = LDS_DT + DT_N * 4;
constexpr int LDS_END = LDS_SCAN + 64;
constexpr float THR2 = 11.5f;

#define KSWZ(row, colB) ((row) * 256 + ((colB) ^ (((row) & 7) << 4)))
#define SBAR() __builtin_amdgcn_sched_barrier(0)
__device__ __forceinline__ int v_st(int k, int c) { const int kk = (k & ~0xC) | ((k & 4) << 1) | ((k & 8) >> 1); return ((kk >> 3) * 4 + (c >> 5)) * 512 + ((kk & 7) * 32 + (c & 31)) * 2; }
__device__ __forceinline__ int v_rd_base(int lane) { return ((lane & 3) << 3) | (((lane >> 2) & 3) << 6) | (((lane >> 4) & 1) << 5) | (((lane >> 5) & 1) << 8); }
constexpr int v_rd_off(int d0, int ks, int half) { return d0 * 512 + ks * 4096 + half * 2048; }
__device__ __forceinline__ int crow(int r, int hi) { return (r & 3) + 8 * (r >> 2) + 4 * hi; }
__device__ __forceinline__ unsigned cvtpk(float lo, float hi) { unsigned r; asm volatile("v_cvt_pk_bf16_f32 %0, %1, %2" : "=v"(r) : "v"(lo), "v"(hi)); return r; }
__device__ __forceinline__ bf16x8 load8(const bf16* p) { return *reinterpret_cast<const bf16x8*>(p); }
__device__ __forceinline__ void mask_tile(f32x16& p0, f32x16& p1, int dq, unsigned W) {
    const float NEG = -__builtin_inff();
#pragma unroll
    for (int r = 0; r < 16; ++r) { const int c = (r & 3) + 8 * (r >> 2);
        if ((unsigned)(dq - c) >= W) p0[r] = NEG;
        if ((unsigned)(dq - c - 32) >= W) p1[r] = NEG; }
}
__device__ __forceinline__ void partialSM(f32x16& p0, f32x16& p1, float& m_reg, float& mn, float& alpha) {
    float pmax = p0[0];
#pragma unroll
    for (int r = 1; r < 16; ++r) pmax = fmaxf(pmax, p0[r]);
#pragma unroll
    for (int r = 0; r < 16; ++r) pmax = fmaxf(pmax, p1[r]);
    { auto rr = __builtin_amdgcn_permlane32_swap(__float_as_uint(pmax), __float_as_uint(pmax), false, false);
      pmax = fmaxf(__uint_as_float(rr[0]), __uint_as_float(rr[1])); }
    if (__builtin_expect(__all((pmax - m_reg) <= THR2), 1)) { mn = m_reg; alpha = 1.f; }
    else { mn = fmaxf(m_reg, pmax); alpha = __builtin_amdgcn_exp2f(m_reg - mn); m_reg = mn; }
#pragma unroll
    for (int r = 0; r < 16; ++r) p0[r] = p0[r] - mn;
#pragma unroll
    for (int r = 0; r < 16; ++r) p1[r] = p1[r] - mn;
#pragma unroll
    for (int r = 0; r < 16; ++r) p0[r] = __builtin_amdgcn_exp2f(p0[r]);
}
__device__ __forceinline__ void finishSM(f32x16& p0, f32x16& p1, float alpha, float& l_reg, bf16x8& pa0, bf16x8& pa1, bf16x8& pa2, bf16x8& pa3) {
#pragma unroll
    for (int r = 0; r < 16; ++r) p1[r] = __builtin_amdgcn_exp2f(p1[r]);
    float ps = 0;
#pragma unroll
    for (int r = 0; r < 16; ++r) ps += p0[r];
#pragma unroll
    for (int r = 0; r < 16; ++r) ps += p1[r];
    { auto rr = __builtin_amdgcn_permlane32_swap(__float_as_uint(ps), __float_as_uint(ps), false, false);
      ps = __uint_as_float(rr[0]) + __uint_as_float(rr[1]); }
    l_reg = l_reg * alpha + ps;
#define PK4(P, B_, OUT) do { unsigned a0 = cvtpk(P[B_+0], P[B_+1]), a1 = cvtpk(P[B_+2], P[B_+3]);                          \
        unsigned b0 = cvtpk(P[B_+4], P[B_+5]), b1 = cvtpk(P[B_+6], P[B_+7]);                                             \
        auto r0 = __builtin_amdgcn_permlane32_swap(a0, b0, false, false); auto r1 = __builtin_amdgcn_permlane32_swap(a1, b1, false, false); \
        u32x4 w = {r0[0], r1[0], r0[1], r1[1]}; OUT = *reinterpret_cast<bf16x8*>(&w); } while (0)
    PK4(p0, 0, pa0); PK4(p0, 8, pa1); PK4(p1, 0, pa2); PK4(p1, 8, pa3);
#undef PK4
}
template <int KB, int MODE>
__device__ __forceinline__ void qkt(f32x16& p0, f32x16& p1, const char* K_lds, int r32, int hi, const bf16x8* qr, const LAS float* cbt, const LAS float* dtab, int kb_, int qm) {
    if (MODE == 0) { const LAS float* cb_ = cbt + (kb_ + 4 * hi);
#pragma unroll
        for (int j_ = 0; j_ < 4; ++j_) { const f32x4 a_ = *(const LAS f32x4*)(cb_ + 8 * j_), b_ = *(const LAS f32x4*)(cb_ + 32 + 8 * j_);
            p0[4 * j_ + 0] = a_[0]; p0[4 * j_ + 1] = a_[1]; p0[4 * j_ + 2] = a_[2]; p0[4 * j_ + 3] = a_[3]; p1[4 * j_ + 0] = b_[0]; p1[4 * j_ + 1] = b_[1]; p1[4 * j_ + 2] = b_[2]; p1[4 * j_ + 3] = b_[3]; } }
    else { const LAS float* tb_ = dtab + (qm - kb_ + (DT_OFF - 59));
#pragma unroll
        for (int r_ = 0; r_ < 16; ++r_) { const int c_ = (r_ & 3) + 8 * (r_ >> 2); p0[r_] = tb_[59 - c_]; p1[r_] = tb_[27 - c_]; } }
    const char* kb[4];
#pragma unroll
    for (int dd = 0; dd < 4; ++dd) kb[dd] = K_lds + KB * SHM_K + KSWZ(r32, (dd * 16 + hi * 8) * 2);
#pragma unroll
    for (int d0 = 0; d0 < 8; ++d0) { const char* a = kb[d0 & 3] + (d0 >> 2) * 128;
        bf16x8 b0 = *reinterpret_cast<const bf16x8*>(a);
        bf16x8 b1 = *reinterpret_cast<const bf16x8*>(a + 32 * 256);
        p0 = __builtin_amdgcn_mfma_f32_32x32x16_bf16(b0, qr[d0], p0, 0, 0, 0);
        p1 = __builtin_amdgcn_mfma_f32_32x32x16_bf16(b1, qr[d0], p1, 0, 0, 0); }
}
template <int VB>
__device__ __forceinline__ void pv_tile(f32x16* o, int vb0, bf16x8 pa0, bf16x8 pa1, bf16x8 pa2, bf16x8 pa3) {
#define TRRD(dst, off) asm volatile("ds_read_b64_tr_b16 %0, %1 offset:%2" : "=&v"(dst) : "v"(vb0), "i"(off) : "memory")
#define PV_D0(d0) do { s16x4 l0, l1, l2, l3, h0, h1, h2, h3; constexpr int b_ = VB * SHM_V + v_rd_off(d0, 0, 0); \
        TRRD(l0, b_); TRRD(h0, b_ + 2048); TRRD(l1, b_ + 4096); TRRD(h1, b_ + 6144); TRRD(l2, b_ + 8192); TRRD(h2, b_ + 10240); TRRD(l3, b_ + 12288); TRRD(h3, b_ + 14336); \
        asm volatile("s_waitcnt lgkmcnt(0)" ::: "memory"); SBAR();   \
        o[d0] = __builtin_amdgcn_mfma_f32_32x32x16_bf16(pa0, (bf16x8){l0[0], l0[1], l0[2], l0[3], h0[0], h0[1], h0[2], h0[3]}, o[d0], 0, 0, 0);   \
        o[d0] = __builtin_amdgcn_mfma_f32_32x32x16_bf16(pa1, (bf16x8){l1[0], l1[1], l1[2], l1[3], h1[0], h1[1], h1[2], h1[3]}, o[d0], 0, 0, 0);   \
        o[d0] = __builtin_amdgcn_mfma_f32_32x32x16_bf16(pa2, (bf16x8){l2[0], l2[1], l2[2], l2[3], h2[0], h2[1], h2[2], h2[3]}, o[d0], 0, 0, 0);   \
        o[d0] = __builtin_amdgcn_mfma_f32_32x32x16_bf16(pa3, (bf16x8){l3[0], l3[1], l3[2], l3[3], h3[0], h3[1], h3[2], h3[3]}, o[d0], 0, 0, 0); } while (0)
    PV_D0(0); PV_D0(1); PV_D0(2); PV_D0(3);
#undef PV_D0
#undef TRRD
}

struct BlockRef { const bf16* Q; const bf16* K; const bf16* V; bf16* O; int P0; int W; };
struct Seam { bf16x8 qr[8]; bf16x8 st_v0, st_v1, st_k0, st_k1; };
__device__ __forceinline__ int swa_jlo(int P0, int W) { const int lowk = P0 - W + 1; return lowk > 0 ? lowk / KVBLK : 0; }
#define ROW(p, k0, rr) ((p) + (size_t)((k0) + (rr)) * D + sc)
#define VMW() asm volatile("s_waitcnt vmcnt(0)" ::: "memory")
#define VMWN(n) asm volatile("s_waitcnt vmcnt(%0)" :: "i"(n) : "memory")
#define SLOAD_H(Kp, Vp, k0) do { S.st_v0 = load8(ROW(Vp, k0, sr)); S.st_v1 = load8(ROW(Vp, k0, 32 + sr));              \
                         S.st_k0 = load8(ROW(Kp, k0, sr)); S.st_k1 = load8(ROW(Kp, k0, 32 + sr)); } while (0)
#define SWRITE_HK(bf) do { *(bf16x8*)(K_lds + (bf) * SHM_K + kws) = S.st_k0; *(bf16x8*)(K_lds + (bf) * SHM_K + kws + 32 * 256) = S.st_k1; } while (0)
#define SWRITE_HV(bf) do { *(bf16x8*)(V_lds + (bf) * SHM_V + vst0) = S.st_v0; *(bf16x8*)(V_lds + (bf) * SHM_V + vst1) = S.st_v1; } while (0)
#define SWRITE_H(bf) do { SWRITE_HV(bf); SWRITE_HK(bf); } while (0)
template <int MODE>
__device__ __forceinline__ void attn_prime(const BlockRef& cur, char* lds, Seam& S) {
    int tid_ = threadIdx.x; asm volatile("" : "+v"(tid_));
    const int tid = tid_, wid = __builtin_amdgcn_readfirstlane(tid >> 6), lane = tid & 63, r32 = lane & 31, hi = lane >> 5;
    const int sr = tid >> 4, sc = (tid & 15) * 8, kws = KSWZ(sr, sc * 2); char* K_lds = lds + 2 * SHM_V;
    const int kb0 = MODE == 0 ? cur.P0 + QB - KVBLK : swa_jlo(cur.P0, cur.W) * KVBLK;
#pragma unroll
    for (int d0 = 0; d0 < 8; ++d0) S.qr[d0] = load8(cur.Q + (size_t)(wid * QBLK + r32) * D + d0 * 16 + hi * 8);
    SLOAD_H(cur.K, cur.V, kb0); VMW(); SWRITE_HK(0);
    __syncthreads();
}
template <int MODE>
__device__ __forceinline__ void attn_block(const BlockRef& cur, const BlockRef& nxt, char* lds, const LAS float* cbt, const LAS float* dtab, Seam& S) {
    int tid_ = threadIdx.x; asm volatile("" : "+v"(tid_));
    const int tid = tid_, wid = __builtin_amdgcn_readfirstlane(tid >> 6), lane = tid & 63, r32 = lane & 31, hi = lane >> 5;
    const int W = cur.W;
    const int j_lo = swa_jlo(cur.P0, W);
    const int j_hi = (cur.P0 + QB - 1) / KVBLK + 1;
    const int NT = j_hi - j_lo;
    const int kbn = MODE == 0 ? nxt.P0 + QB - KVBLK : swa_jlo(nxt.P0, nxt.W) * KVBLK;
    const int qlo = cur.P0 + wid * QBLK, qm = qlo + r32 - 4 * hi;
    char* V_lds = lds; char* K_lds = lds + 2 * SHM_V;
    float* ws = (float*)(lds + LDS_WSF) + wid * 64; float* li_l = ws, * al_l = ws + 32;
    float m_reg = -1e30f, l_reg = 0; f32x16 o[4] = {};
    const int sr = tid >> 4, sc = (tid & 15) * 8, vst0 = v_st(sr, sc), vst1 = v_st(32 + sr, sc), kws = KSWZ(sr, sc * 2);
    const int vb0 = (int)(uintptr_t)V_lds + v_rd_base(lane);
    const bf16* Kh = cur.K; const bf16* Vh = cur.V;
#define RESC(a) do { if (__any((a) < 1.f)) { if (hi == 0) al_l[r32] = (a); asm volatile("s_waitcnt lgkmcnt(0)" ::: "memory");              \
                     for (int d_ = 0; d_ < 4; ++d_) for (int r = 0; r < 16; ++r) o[d_][r] *= al_l[crow(r, hi)]; } } while (0)
#define KBASE(t) ((MODE == 0 ? (j_hi - 1 - (t)) : (j_lo + (t))) * KVBLK)
#define MASKT(P0_, P1_, t) do { if (MODE == 0) { const int kb_ = KBASE(t); if (kb_ + KVBLK - 1 > qlo) mask_tile(P0_, P1_, qm - kb_, (unsigned)W); } } while (0)
    constexpr int NQL = 8;
#define SEAM_K0() do { VMWN(NQL); SWRITE_HK(0); SBAR(); } while (0)
    f32x16 pA0, pA1, pB0, pB1; float mnA, mnB, alA, alB; bf16x8 pa0, pa1, pa2, pa3;
    SWRITE_HV(0); SBAR();
    if (NT > 1) { SLOAD_H(Kh, Vh, KBASE(1)); }
    SBAR(); qkt<0, MODE>(pA0, pA1, K_lds, r32, hi, S.qr, cbt, dtab, KBASE(0), qm);
    MASKT(pA0, pA1, 0); partialSM(pA0, pA1, m_reg, mnA, alA);
    if (NT > 1) { VMW(); SWRITE_H(1); }
    __syncthreads();
#define HALF_STEP(PX0, PX1, mnX, alX, PY0, PY1, alY, t, KB, VB, SB) do {                                                      \
        SBAR(); qkt<KB, MODE>(PX0, PX1, K_lds, r32, hi, S.qr, cbt, dtab, KBASE(t), qm);                                             \
        finishSM(PY0, PY1, alY, l_reg, pa0, pa1, pa2, pa3); SBAR();                                                           \
        if ((t) + 1 < NT) { SLOAD_H(Kh, Vh, KBASE((t) + 1)); SBAR(); }                                               \
        pv_tile<VB>(o, vb0, pa0, pa1, pa2, pa3); MASKT(PX0, PX1, (t)); partialSM(PX0, PX1, m_reg, mnX, alX);                                        \
        __syncthreads();                                                                                                      \
        if ((t) + 1 < NT) { VMW(); SWRITE_H(SB); }                                                                          \
        RESC(alX); __syncthreads(); } while (0)
    for (int t = 1; t + 1 < NT; t += 2) {
        HALF_STEP(pB0, pB1, mnB, alB, pA0, pA1, alA, t, 1, 0, 0);
        HALF_STEP(pA0, pA1, mnA, alA, pB0, pB1, alB, t + 1, 0, 1, 1);
    }
    const bool even = (NT & 1) == 0;
    if (even) { SBAR(); qkt<1, MODE>(pB0, pB1, K_lds, r32, hi, S.qr, cbt, dtab, KBASE(NT - 1), qm); SBAR(); }
    SLOAD_H(nxt.K, nxt.V, kbn); SBAR();
#pragma unroll
    for (int d0 = 0; d0 < 8; ++d0) S.qr[d0] = load8(nxt.Q + (size_t)(wid * QBLK + r32) * D + d0 * 16 + hi * 8);
    SBAR();
    finishSM(pA0, pA1, alA, l_reg, pa0, pa1, pa2, pa3); SBAR();
    pv_tile<0>(o, vb0, pa0, pa1, pa2, pa3);
    if (even) { MASKT(pB0, pB1, NT - 1); partialSM(pB0, pB1, m_reg, mnB, alB); __syncthreads(); RESC(alB);
        finishSM(pB0, pB1, alB, l_reg, pa0, pa1, pa2, pa3); SBAR(); pv_tile<1>(o, vb0, pa0, pa1, pa2, pa3); }
    SBAR(); SEAM_K0();
    if (hi == 0) li_l[r32] = l_reg; asm volatile("s_waitcnt lgkmcnt(0)" ::: "memory");
    float rli[16];
#pragma unroll
    for (int r = 0; r < 16; ++r) rli[r] = __builtin_amdgcn_rcpf(li_l[crow(r, hi)]);
    int lo_ = 4 * hi * LDO + r32; asm volatile("" : "+v"(lo_));
#pragma unroll
    for (int r = 0; r < 16; ++r) { bf16* rowp = cur.O + (size_t)(wid * QBLK + (r & 3) + 8 * (r >> 2)) * LDO;
#pragma unroll
        for (int d0 = 0; d0 < 4; ++d0) { const float v = o[d0][r] * rli[r];
            const float vn = __shfl_xor(v, 1);
            if ((r32 & 1) == 0) *(unsigned*)(rowp + lo_ + d0 * 32) = cvtpk(v, vn); } }
    __syncthreads();
#undef RESC
#undef KBASE
#undef MASKT
#undef SEAM_K0
#undef HALF_STEP
}
#undef ROW
#undef VMW
#undef VMWN
#undef SLOAD_H
#undef SWRITE_HK
#undef SWRITE_HV
#undef SWRITE_H

__device__ __forceinline__ void build_cb(const float* lf, int n, LAS float* cbt, LAS float* scan, int tid_in) {
    int tid = tid_in; asm volatile("" : "+v"(tid));
    const int lane = tid & 63, wid = tid >> 6, i0 = tid * 16;
    f32x4 v[4]; float tot = 0.f;
    if (i0 < n) {
#pragma unroll
        for (int j = 0; j < 4; ++j) v[j] = *(const f32x4*)(lf + i0 + 4 * j);
    } else {
#pragma unroll
        for (int j = 0; j < 4; ++j) v[j] = (f32x4){0.f, 0.f, 0.f, 0.f};
    }
#pragma unroll
    for (int j = 0; j < 4; ++j) { v[j][0] += tot; v[j][1] += v[j][0]; v[j][2] += v[j][1]; v[j][3] += v[j][2]; tot = v[j][3]; }
    float inc = tot;
#pragma unroll
    for (int o = 1; o < 64; o <<= 1) { const float t = __shfl_up(inc, o); if (lane >= o) inc += t; }
    if (lane == 63) scan[wid] = inc;
    __syncthreads();
    float base = inc - tot;
    for (int w = 0; w < wid; ++w) base += scan[w];
    if (i0 < n) {
#pragma unroll
        for (int j = 0; j < 4; ++j) { f32x4 o4; o4[0] = -(v[j][0] + base) * LOG2E; o4[1] = -(v[j][1] + base) * LOG2E; o4[2] = -(v[j][2] + base) * LOG2E; o4[3] = -(v[j][3] + base) * LOG2E;
            *(LAS f32x4*)(cbt + i0 + 4 * j) = o4; }
    }
    __syncthreads();
}
#undef SBAR
}

#define XB_TMO      128
#define XB_XCNT(j)  (256  + 64 * (j))
#define XB_XSUB(j)  (1280 + 64 * (j))
#define XB_XGEN(j)  (2304 + 64 * (j))
#define XB_TOP      3328
#define XB_TOPGEN   3392
#define XCD_BAR_WORDS 3456
#define XB_SPIN_CAP (1u << 18)

__device__ __forceinline__ unsigned xb_ld(unsigned* p)              { return __hip_atomic_load(p, __ATOMIC_RELAXED, __HIP_MEMORY_SCOPE_AGENT); }
__device__ __forceinline__ unsigned xb_add(unsigned* p, unsigned v) { return __hip_atomic_fetch_add(p, v, __ATOMIC_RELAXED, __HIP_MEMORY_SCOPE_AGENT); }
__device__ __forceinline__ unsigned xb_xcc_id() { return (unsigned)__builtin_amdgcn_s_getreg((3 << 11) | 20) & 0xFu; }
#define XB_SPIN(cond, bar) do { unsigned _sp = 0; while (cond) { __builtin_amdgcn_s_sleep(1); \
    if ((++_sp & 255u) == 0u) { if (xb_ld(&(bar)[XB_TMO])) break; if (_sp > XB_SPIN_CAP) { atomicAdd(&(bar)[XB_TMO], 1u); break; } } } } while (0)

struct XcdBarrier {
    unsigned* bar; unsigned x;
    volatile LAS unsigned* st;
};

__device__ __forceinline__ XcdBarrier xcd_barrier_post(unsigned* bar, volatile LAS unsigned* st) {
    XcdBarrier b; b.bar = bar; b.x = xb_xcc_id(); b.st = st;
    if (threadIdx.x == 0) (void)xb_add(&bar[XB_XCNT(b.x)], 1u);
    return b;
}
__device__ __forceinline__ void xcd_barrier_complete(unsigned* bar, unsigned x, unsigned& nloc, unsigned& nx) {
    const unsigned G = gridDim.x * gridDim.y * gridDim.z;
    unsigned sum, cnt, mine, sp = 0u;
    for (;;) {
        sum = 0u; cnt = 0u; mine = 0u;
#pragma unroll
        for (unsigned j = 0; j < 16; ++j) { const unsigned c = xb_ld(&bar[XB_XCNT(j)]); sum += c; cnt += (c > 0u) ? 1u : 0u; mine = (j == x) ? c : mine; }
        if (sum == G) break;
        __builtin_amdgcn_s_sleep(1);
        if ((++sp & 255u) == 0u) { if (xb_ld(&bar[XB_TMO])) break; if (sp > XB_SPIN_CAP) { atomicAdd(&bar[XB_TMO], 1u); break; } }
    }
    nloc = mine > 0u ? mine : 1u; nx = cnt > 0u ? cnt : 1u;
}

__device__ __forceinline__ void xcd_barrier(const XcdBarrier& b) {
    asm volatile("s_waitcnt vmcnt(0)" ::: "memory");
    __syncthreads();
    if (threadIdx.x == 0) {
        unsigned* bar = b.bar;
        __builtin_amdgcn_s_waitcnt(0);
        unsigned nloc = b.st[0], nx = b.st[1];
        if (nloc == 0u) { xcd_barrier_complete(bar, b.x, nloc, nx); b.st[0] = nloc; b.st[1] = nx; }
        const unsigned old = xb_add(&bar[XB_XSUB(b.x)], 1u);
        const unsigned gen = old / nloc;
        if (old + 1u == (gen + 1u) * nloc) {
            __builtin_amdgcn_fence(__ATOMIC_RELEASE, "agent");
            asm volatile("s_waitcnt vmcnt(0)" ::: "memory");
            const unsigned og = xb_add(&bar[XB_TOP], 1u);
            const unsigned tg = og / nx;
            if (og + 1u == (tg + 1u) * nx) xb_add(&bar[XB_TOPGEN], 1u);
            else XB_SPIN(xb_ld(&bar[XB_TOPGEN]) == tg, bar);
            __builtin_amdgcn_fence(__ATOMIC_ACQUIRE, "agent");
            xb_add(&bar[XB_XGEN(b.x)], 1u);
            asm volatile("s_waitcnt vmcnt(0)" ::: "memory");
        } else {
            XB_SPIN(xb_ld(&bar[XB_XGEN(b.x)]) == gen, bar);
            __builtin_amdgcn_fence(__ATOMIC_ACQUIRE, "agent");
            asm volatile("s_waitcnt vmcnt(0)" ::: "memory");
        }
    }
    __syncthreads();
}

struct Args { const float* in[18]; float* out; unsigned char* ws; int ph_lo, ph_hi; };

__constant__ float c_invfreq[16] = {1.000000000e+00f, 4.403665960e-01f, 1.939227432e-01f, 8.539710194e-02f, 3.760603070e-02f, 1.656043902e-02f, 7.292664610e-03f, 3.211445874e-03f,
                                    1.414213562e-03f, 6.227723788e-04f, 2.742481884e-04f, 1.207697351e-04f, 5.318296098e-05f, 2.341999971e-05f, 1.031338616e-05f, 4.541670478e-06f};

__device__ __forceinline__ int rowmap(int mode, int n, int row_off) {
    if (mode == 0) return n + row_off;
    if (mode == 1) return (n >> 7) * 256 + (n & 127);
    if (mode == 2) return (n >> 7) * 256 + 128 + (n & 127);
    if (n < 6144) { const int seg = n >> 10, d = n & 127; if (seg < 2 && d < 32) { const int dn = d < 16 ? 2 * d : 2 * (d - 16) + 1; return n - d + dn; } return n; }
    if (n < 6152) return 10240 + (n - 6144);
    if (n < 8200) return 6144 + (n - 6152);
    return 8192 + (n - 8200);
}
struct CvtDesc { const float* W; int K, N; bf16_t* WT; int ldk, kofs, mode; const float* gain; int item; };
constexpr int CVT_SCR = 64 * 65 * 4;
__device__ __forceinline__ void cvt_load(const CvtDesc& d, f32x4 (&v)[16], int lane) {
    const int nblk = (d.N + 63) / 64, kb = d.item / nblk, nb = d.item - kb * nblk, k0 = 64 * kb, n0 = 64 * nb;
    const int nn = n0 + 4 * (lane & 15); const bool ok = nn < d.N;
    const float* p = d.W + (size_t)(k0 + (lane >> 4)) * d.N + nn;
#pragma unroll
    for (int i = 0; i < 16; ++i) v[i] = ok ? *(const f32x4*)(p + (size_t)(4 * i) * d.N) : (f32x4){0.f, 0.f, 0.f, 0.f};
}
__device__ __forceinline__ void cvt_store(const CvtDesc& d, const f32x4 (&v)[16], LAS float* scr, int lane) {
    const int nblk = (d.N + 63) / 64, kb = d.item / nblk, nb = d.item - kb * nblk, k0 = 64 * kb, n0 = 64 * nb;
#pragma unroll
    for (int i = 0; i < 16; ++i) { LAS float* q = scr + (4 * i + (lane >> 4)) * 65 + 4 * (lane & 15); q[0] = v[i][0]; q[1] = v[i][1]; q[2] = v[i][2]; q[3] = v[i][3]; }
    asm volatile("s_waitcnt lgkmcnt(0)" ::: "memory");
    const int c = lane & 7;
    f32x4 g0 = {1.f, 1.f, 1.f, 1.f}, g1 = {1.f, 1.f, 1.f, 1.f};
    if (d.gain) { g0 = *(const f32x4*)(d.gain + k0 + 8 * c); g1 = *(const f32x4*)(d.gain + k0 + 8 * c + 4); }
#pragma unroll
    for (int j = 0; j < 8; ++j) { const int n = (lane >> 3) + 8 * j; const LAS float* s = scr + (8 * c) * 65 + n;
        u32x4 o; o.x = cvt_pk_bf16(s[0 * 65] * g0[0], s[1 * 65] * g0[1]); o.y = cvt_pk_bf16(s[2 * 65] * g0[2], s[3 * 65] * g0[3]);
        o.z = cvt_pk_bf16(s[4 * 65] * g1[0], s[5 * 65] * g1[1]); o.w = cvt_pk_bf16(s[6 * 65] * g1[2], s[7 * 65] * g1[3]);
        if (n0 + n < d.N) *(u32x4*)(d.WT + (size_t)rowmap(d.mode, n0 + n, 0) * d.ldk + d.kofs + k0 + 8 * c) = o; }
    asm volatile("s_waitcnt lgkmcnt(0)" ::: "memory");
}
struct CvtTab { const float* in[18]; bf16_t *Wgu, *Wd, *Win, *Wp, *Wout; };
constexpr int CI_G = (DM / 64) * (FF / 64), CI_D = (FF / 64) * (DM / 64), CI_IN = (DM / 64) * ((INC + 63) / 64), CI_P = (1024 / 64) * (DM / 64), CI_O = (DM / 64) * (DM / 64);
constexpr int CVT_N0 = 2 * CI_G + CI_D + CI_IN + 2 * CI_P + CI_O;
constexpr int CVT_N1 = 2 * CI_G + CI_D;
__device__ __forceinline__ CvtDesc cvt_decode(const CvtTab& t, int list, int it) {
    CvtDesc d; int r = it; const int fb = list == 0 ? 2 : 14; const float* gn = t.in[list == 0 ? 1 : 13];
    if (r < CI_G) { d = CvtDesc{t.in[fb], DM, FF, t.Wgu, DM, 0, 1, gn, r}; return d; } r -= CI_G;
    if (r < CI_G) { d = CvtDesc{t.in[fb + 1], DM, FF, t.Wgu, DM, 0, 2, gn, r}; return d; } r -= CI_G;
    if (r < CI_D) { d = CvtDesc{t.in[fb + 2], FF, DM, t.Wd, FF, 0, 0, nullptr, r}; return d; } r -= CI_D;
    if (r < CI_IN) { d = CvtDesc{t.in[6], DM, INC, t.Win, DM, 0, 3, t.in[5], r}; return d; } r -= CI_IN;
    if (r < CI_P) { d = CvtDesc{t.in[10], 1024, DM, t.Wp, DM, 0, 0, nullptr, r}; return d; } r -= CI_P;
    if (r < CI_P) { d = CvtDesc{t.in[11], 1024, DM, t.Wp, DM, 1024, 0, nullptr, r}; return d; } r -= CI_P;
    d = CvtDesc{t.in[12], DM, DM, t.Wout, DM, 0, 0, nullptr, r}; return d;
}
__device__ __forceinline__ void convert_list(const CvtTab& t, int list, int nitems, LAS float* scr, int gw, int NGW, int lane) {
    f32x4 va[16], vb[16];
    CvtDesc da, db;
    int it = gw;
    if (it < nitems) { da = cvt_decode(t, list, it); cvt_load(da, va, lane); }
    while (it < nitems) {
        const int it2 = it + NGW;
        if (it2 < nitems) { db = cvt_decode(t, list, it2); cvt_load(db, vb, lane); }
        cvt_store(da, va, scr, lane);
        const int it3 = it2 + NGW;
        if (it3 < nitems) { da = cvt_decode(t, list, it3); cvt_load(da, va, lane); }
        if (it2 < nitems) cvt_store(db, vb, scr, lane);
        it = it3;
    }
}

#ifndef MK_LAUNCHES
#define MK_LAUNCHES 1
#endif
constexpr int LDS_BYTES = 147456;

__global__ void __launch_bounds__(512, 2) fwd_megakernel(Args a) {
    extern __shared__ __attribute__((aligned(16))) unsigned char lds_raw[];
#if MK_LAUNCHES == 1
    cg::grid_group grid = cg::this_grid();
#endif
    LAS unsigned char* lds = (LAS unsigned char*)lds_raw;

#if MK_LAUNCHES == 1
    { volatile LAS unsigned* st0 = (volatile LAS unsigned*)(lds + LDS_BYTES - 64); if (threadIdx.x < 16) st0[threadIdx.x] = 0u; }
    __syncthreads();
    const XcdBarrier xbar = xcd_barrier_post((unsigned*)(a.ws + WS_BAR), (volatile LAS unsigned*)(lds + LDS_BYTES - 64));
#define GSYNC() xcd_barrier(xbar)
#define IN(k) true
    grid.sync();
#else
#define GSYNC() do { } while (0)
#define IN(k) (a.ph_lo == (k))
#endif
#define PHASE_IDS int tid_ = threadIdx.x; asm volatile("" : "+v"(tid_)); const int tid = tid_, lane = tid & 63, wave = __builtin_amdgcn_readfirstlane(tid >> 6); \
    const int gw = vcu * 8 + wave, NGW = G * 8, gt = vcu * 512 + tid, NGT = G * 512; LAS float* scr = (LAS float*)(lds + wave * CVT_SCR); (void)gw; (void)NGW; (void)gt; (void)NGT; (void)scr; (void)lane;
    const int G = gridDim.x, bx = blockIdx.x;
    const int vcu = (G % 8 == 0) ? (bx % 8) * (G / 8) + bx / 8 : bx;
    unsigned char* ws = a.ws;
    float* ssq0 = (float*)(ws + WS_SSQ); float* ssq1 = ssq0 + T; float* ssq2 = ssq1 + T; float* ssq3 = ssq2 + T;
    float* rope = (float*)(ws + WS_ROPE); float* logf = (float*)(ws + WS_LOGF);
    bf16_t* Wgu = (bf16_t*)(ws + WS_WGU); bf16_t* Wd = (bf16_t*)(ws + WS_WD); bf16_t* Win = (bf16_t*)(ws + WS_WIN);
    bf16_t* Wp = (bf16_t*)(ws + WS_WP); bf16_t* Wout = (bf16_t*)(ws + WS_WOUT);
    bf16_t* xb = (bf16_t*)(ws + WS_XB); bf16_t* act = (bf16_t*)(ws + WS_BIG); bf16_t* qkv = (bf16_t*)(ws + WS_BIG); bf16_t* merged = (bf16_t*)(ws + WS_BIG);
    bf16_t* gates = (bf16_t*)(ws + WS_GATES);
    const float* x = a.in[0]; float* out = a.out;

    if (IN(0))
    {
        PHASE_IDS
#ifndef REP0
#define REP0 1
#endif
        for (int rep0 = 0; rep0 < REP0; ++rep0) {
        { CvtTab ct; for (int i = 0; i < 18; ++i) ct.in[i] = a.in[i]; ct.Wgu = Wgu; ct.Wd = Wd; ct.Win = Win; ct.Wp = Wp; ct.Wout = Wout;
          convert_list(ct, 0, CVT_N0, scr, gw, NGW, lane); }
#ifdef DIAG_POISON
        { const u32x4 pz = {0xAAAAAAAAu, 0xAAAAAAAAu, 0xAAAAAAAAu, 0xAAAAAAAAu};
          for (size_t i = gt; i < (WS_END - WS_BIG) / 16; i += NGT) *(u32x4*)(ws + WS_BIG + i * 16) = pz;
          for (size_t i = gt; i < (512 * 1024) / 16; i += NGT) *(u32x4*)(ws + WS_LOGF + i * 16) = pz;
          for (size_t i = gt; i < ((size_t)T * DM * 4) / 16; i += NGT) *(u32x4*)((unsigned char*)out + i * 16) = pz; }
#endif
        for (int i = gt; i < (NIN - INC) * DM / 8; i += NGT) *(u32x4*)(Win + (size_t)INC * DM + (size_t)i * 8) = (u32x4){0u, 0u, 0u, 0u};
        for (int i = gt; i < 3 * T; i += NGT) ssq1[i] = 0.f;
        for (int i = gt; i < SEQ * 16; i += NGT) { const int pos = i >> 4, f = i & 15; const float ang = (float)pos * c_invfreq[f];
            double rev = (double)ang * 0.15915494309189535; rev -= __builtin_rint(rev); const float fr = (float)rev;
            rope[2 * i] = __builtin_amdgcn_cosf(fr); rope[2 * i + 1] = __builtin_amdgcn_sinf(fr); }
        for (int m = gw; m < T; m += NGW) { const f32x4* xr = (const f32x4*)(x + (size_t)m * DM) + lane; float s = 0.f;
            u32x2* o8 = (u32x2*)(xb + (size_t)m * DM) + lane;
#pragma unroll
            for (int j = 0; j < 8; ++j) { const f32x4 v = xr[64 * j]; s += (v[0] * v[0] + v[1] * v[1]) + (v[2] * v[2] + v[3] * v[3]);
                u32x2 w; w.x = cvt_pk_bf16(v[0], v[1]); w.y = cvt_pk_bf16(v[2], v[3]); o8[64 * j] = w; }
            s = wave_sum(s); if (lane == 0) ssq0[m] = s; }
        asm volatile("" ::: "memory"); }
    }
    GSYNC();
    if (IN(1))
    { pg8::Gemm g{xb, Wgu, DM, DM, DM}; pg8::StaticOrder S; S.init(T, NGU, G, bx); pg8::EpiSwiGLU E{act, ssq0}; pg8::gemm_phase(lds, g, S, E); }
    GSYNC();
    if (IN(2))
    { pg8::Gemm g{act, Wd, FF, FF, FF}; pg8::StaticOrder S; S.init(T, DM, G, bx); pg8::EpiResid E{x, out, xb, ssq1, 0.5f}; pg8::gemm_phase(lds, g, S, E); }
    GSYNC();
    if (IN(3))
    { pg8::Gemm g{xb, Win, DM, DM, DM}; pg8::StaticOrder S; S.init(T, 10240, G, bx); pg8::EpiWin E{qkv, gates, logf, ssq1, rope, a.in[7], a.in[8], a.in[9]}; pg8::gemm_phase(lds, g, S, E); }
    if (IN(3))
    {
        PHASE_IDS
        const bf16_t* Wf = Win + (size_t)10240 * DM; const float* b_forget = a.in[7];
        for (int m = gw; m < T; m += NGW) {
            const u32x4* xr = (const u32x4*)(xb + (size_t)m * DM) + lane; u32x4 xv[4];
#pragma unroll
            for (int j = 0; j < 4; ++j) xv[j] = xr[64 * j];
            float accf[8];
#pragma unroll
            for (int h = 0; h < 8; ++h) { const u32x4* wr_ = (const u32x4*)(Wf + (size_t)h * DM) + lane; float sacc = 0.f;
#pragma unroll
                for (int j = 0; j < 4; ++j) { const u32x4 wv = wr_[64 * j];
                    sacc += bf_lo(xv[j].x) * bf_lo(wv.x) + bf_hi(xv[j].x) * bf_hi(wv.x) + bf_lo(xv[j].y) * bf_lo(wv.y) + bf_hi(xv[j].y) * bf_hi(wv.y)
                          + bf_lo(xv[j].z) * bf_lo(wv.z) + bf_hi(xv[j].z) * bf_hi(wv.z) + bf_lo(xv[j].w) * bf_lo(wv.w) + bf_hi(xv[j].w) * bf_hi(wv.w); }
                accf[h] = wave_sum(sacc); }
            if (lane < 8) { float v = accf[0];
#pragma unroll
                for (int h = 1; h < 8; ++h) v = (lane == h) ? accf[h] : v;
                const float z = v * pg8::rstd_of(ssq1, m) + b_forget[lane];
                const float ls = fminf(z, 0.f) - __logf(1.f + __expf(-fabsf(z)));
                logf[(size_t)((m >> 13) * NH + lane) * SEQ + (m & (SEQ - 1))] = ls; }
        }
    }
    GSYNC();
    if (IN(4))
    {
        using namespace att;
        PHASE_IDS
        char* al = (char*)lds_raw;
        LAS float* cbt = (LAS float*)(lds + LDS_CB); LAS float* dtab = (LAS float*)(lds + LDS_DT); LAS float* scan = (LAS float*)(lds + LDS_SCAN);
        for (int i = tid; i < DT_N; i += 512) { const int dl = i - DT_OFF; float v = -__builtin_inff();
            if (dl >= 0 && dl <= 2048) { const int mlt = (dl <= 128 ? 1 : 0) + (((dl & 3) == 0 && dl <= 512) ? 1 : 0) + (((dl & 15) == 0) ? 1 : 0);
                v = mlt == 0 ? -__builtin_inff() : (mlt == 1 ? 0.f : (mlt == 2 ? 1.f : 1.5849625007211562f)); }
            dtab[i] = v; }
        __syncthreads();
        constexpr int NFOX = 256, NDIL = 256, TOTAL = NFOX + NDIL;
        const bf16* qkvb = (const bf16*)qkv; bf16* ycat = (bf16*)xb;
        struct Item { int mode, bh, qb0, qb1; };
        auto decode = [&](int L) { Item it; const unsigned long long FA = 0x5432DB910AFEC876ull;
            if (L < NFOX) { it.mode = 0; it.bh = L >> 4; const int sl = L & 15; it.qb0 = (int)((FA >> (4 * sl)) & 15);
                const int sums = sl < 8 ? 37 - sl : (sl < 12 ? 29 : 28); it.qb1 = sums - it.qb0; }
            else { const int l2 = L - NFOX; it.mode = 1; it.bh = l2 >> 4; const int sl = l2 & 15; if (sl < 8) { it.qb0 = sl; it.qb1 = 8 + sl; } else { it.qb0 = 2 * sl; it.qb1 = 2 * sl + 1; } }
            return it; };
        auto mkref = [&](const Item& it, int pass) { const int qb = pass ? it.qb1 : it.qb0; BlockRef r; const size_t seg = (size_t)T * 1024; const int sb = it.mode == 0 ? 3 : 0;
            const size_t hb = (size_t)it.bh * SEQ * HD;
            r.Q = qkvb + (sb + 0) * seg + hb + (size_t)qb * QB * HD; r.K = qkvb + (sb + 1) * seg + hb; r.V = qkvb + (sb + 2) * seg + hb;
            r.O = ycat + ((size_t)(it.bh >> 3) * SEQ + (size_t)qb * QB) * LDO + (it.mode == 0 ? 1024 : 0) + (it.bh & 7) * HD; r.P0 = qb * QB; r.W = it.mode == 0 ? (1 << 30) : 2049;
            return r; };
#define ATT_STREAM(MODE_, LBEG, LEND) do { int L = (LBEG) + vcu; if (L < (LEND)) { \
            Item it = decode(L); int pass = 0; BlockRef cur = mkref(it, 0); Seam S; \
            attn_prime<MODE_>(cur, al, S); \
            for (;;) { \
                const bool more_pass = pass == 0 && it.qb1 != it.qb0, more_item = L + G < (LEND), last = !more_pass && !more_item; \
                Item itn = it; int passn = pass + 1, Ln = L; \
                if (!more_pass) { passn = 0; Ln = more_item ? L + G : L; itn = decode(Ln); } \
                const BlockRef nxt = last ? cur : mkref(itn, passn); \
                if (MODE_ == 0 && pass == 0) { const int mq = it.qb0 > it.qb1 ? it.qb0 : it.qb1; build_cb(logf + (size_t)it.bh * SEQ, (mq + 1) * QB, cbt, scan, tid); } \
                attn_block<MODE_>(cur, nxt, al, cbt, dtab, S); \
                if (last) break; \
                cur = nxt; it = itn; pass = passn; L = Ln; \
            } } } while (0)
#ifndef REP4
#define REP4 1
#endif
        for (int rep4 = 0; rep4 < REP4; ++rep4) {
        ATT_STREAM(0, 0, NFOX);
        __syncthreads();
        ATT_STREAM(1, NFOX, TOTAL);
        __syncthreads(); }
#undef ATT_STREAM
    }
    GSYNC();
    if (IN(5))
    {
        PHASE_IDS
        { CvtTab ct; for (int i = 0; i < 18; ++i) ct.in[i] = a.in[i]; ct.Wgu = Wgu; ct.Wd = Wd; ct.Win = Win; ct.Wp = Wp; ct.Wout = Wout;
          convert_list(ct, 1, CVT_N1, scr, gw, NGW, lane); }
        __syncthreads();
        pg8::Gemm g{xb, Wp, 1024, DM, DM}; pg8::StaticOrder S; S.init(T, DM, G, bx, 2); pg8::EpiProj E{gates, merged}; pg8::gemm_phase(lds, g, S, E);
    }
    GSYNC();
    if (IN(6))
    { pg8::Gemm g{merged, Wout, DM, DM, DM}; pg8::StaticOrder S; S.init(T, DM, G, bx); pg8::EpiResid E{out, out, xb, ssq2, 1.0f}; pg8::gemm_phase(lds, g, S, E); }
    GSYNC();
    if (IN(7))
    { pg8::Gemm g{xb, Wgu, DM, DM, DM}; pg8::StaticOrder S; S.init(T, NGU, G, bx); pg8::EpiSwiGLU E{act, ssq2}; pg8::gemm_phase(lds, g, S, E); }
    GSYNC();
    if (IN(8))
    { pg8::Gemm g{act, Wd, FF, FF, FF}; pg8::StaticOrder S; S.init(T, DM, G, bx); pg8::EpiResid E{out, out, nullptr, ssq3, 0.5f}; pg8::gemm_phase(lds, g, S, E); }
    GSYNC();
    if (IN(9))
    {
        PHASE_IDS
        const float* fn = a.in[17];
        for (int m = gw; m < T; m += NGW) { f32x4* xr = (f32x4*)(out + (size_t)m * DM) + lane; const float rs = rsqrtf(ssq3[m] * (1.f / (float)DM) + EPS);
#pragma unroll
            for (int j = 0; j < 8; ++j) { const f32x4 gg = *((const f32x4*)fn + lane + 64 * j); f32x4 v = xr[64 * j]; v = v * rs * gg; xr[64 * j] = v; } }
    }
}

extern "C" void kernel_launch(void* const* d_in, const int* in_sizes, int n_in, void* d_out, int out_size, void* d_ws, size_t ws_size, hipStream_t stream) {
    static int grid = 0;
    if (grid == 0) {
        if (n_in != 18 || out_size != T * DM || ws_size < WS_END) { fprintf(stderr, "kernel_launch: unexpected shapes n_in %d out %d ws %zu\n", n_in, out_size, ws_size); grid = -1; return; }
        int dev = 0, cus = 0, per_cu = 0;
        (void)hipGetDevice(&dev); (void)hipDeviceGetAttribute(&cus, hipDeviceAttributeMultiprocessorCount, dev);
        if (hipFuncSetAttribute((const void*)fwd_megakernel, hipFuncAttributeMaxDynamicSharedMemorySize, LDS_BYTES) != hipSuccess) { fprintf(stderr, "hipFuncSetAttribute failed\n"); grid = -1; return; }
        if (hipOccupancyMaxActiveBlocksPerMultiprocessor(&per_cu, (const void*)fwd_megakernel, 512, LDS_BYTES) != hipSuccess || per_cu < 1) { fprintf(stderr, "occupancy query: %d\n", per_cu); per_cu = 1; }
        (void)hipGetLastError();
        grid = cus * per_cu;
        fprintf(stderr, "kernel_launch: grid %d (cus %d x %d)\n", grid, cus, per_cu);
    }
    if (grid < 0) return;
    (void)hipMemsetAsync((char*)d_ws + WS_BAR, 0, XCD_BAR_WORDS * 4, stream);
    Args a{};
    for (int i = 0; i < 18; ++i) a.in[i] = (const float*)d_in[i];
    a.out = (float*)d_out; a.ws = (unsigned char*)d_ws;
#if MK_LAUNCHES == 1
    a.ph_lo = 0; a.ph_hi = 10;
    void* args[] = {&a};
    hipError_t e = hipLaunchCooperativeKernel((const void*)fwd_megakernel, dim3(grid), dim3(512), args, LDS_BYTES, stream);
    if (e != hipSuccess) fprintf(stderr, "cooperative launch failed: %s (grid %d)\n", hipGetErrorString(e), grid);
#else
    for (int k = 0; k < 10; ++k) { a.ph_lo = k; a.ph_hi = k + 1; hipLaunchKernelGGL(fwd_megakernel, dim3(grid), dim3(512), LDS_BYTES, stream, a); }
#endif
}
```
